# Optimizing an MI355X kernel written in HIP

```python
import math
import jax, jax.numpy as jnp
from jax import lax
import numpy as np

D_MODEL = 1024
BATCH = 8
SEQ = 2048
DEPTH = 4

N_BRANCHES = 3
SSM_WIDTH = D_MODEL // 2
SSM_GROUP = 16
SSM_GROUPS = SSM_WIDTH // SSM_GROUP
SSM_STATE = 64
SSM_DT_MIN = 1e-3
SSM_DT_MAX = 1e-1
MLSTM_WIDTH = D_MODEL // 2
MLSTM_HEADS = 4
MLSTM_HEAD_DIM = MLSTM_WIDTH // MLSTM_HEADS
MLSTM_CHUNK = 128
CONV_WIDTH = 4
MOBA_WIDTH = D_MODEL // 2
MOBA_HEADS = 8
MOBA_HEAD_DIM = MOBA_WIDTH // MOBA_HEADS
MOBA_BLOCK = 256
MOBA_TOPK = 3
MOBA_QUERY_BLOCK = 32
REL_BUCKETS = 32
REL_MAX_DIST = 128
D_FF = 4 * D_MODEL
RMS_EPS = 1e-6
NEG_INF = -1e30

IN_SIZES = (SSM_WIDTH,
            MLSTM_WIDTH, MLSTM_WIDTH, MLSTM_WIDTH, MLSTM_WIDTH, MLSTM_HEADS, MLSTM_HEADS,
            MOBA_WIDTH, MOBA_WIDTH, MOBA_WIDTH,
            N_BRANCHES * D_MODEL)
IN_COLS = sum(IN_SIZES)

kernel_name = "hybrid_s5_mlstm_moba_gated_block"


def rms_norm(x, g):
    xf = x.astype(jnp.float32)
    y = xf * lax.rsqrt(jnp.mean(xf * xf, axis=-1, keepdims=True) + RMS_EPS)
    return (y * g.astype(jnp.float32)).astype(x.dtype)


def split_cols(t, sizes):
    outs, start = [], 0
    for s in sizes:
        outs.append(t[..., start:start + s])
        start += s
    return outs


def causal_conv(x, w):
    k, c = w.shape
    return lax.conv_general_dilated(x, w[:, None, :], window_strides=(1,), padding=[(k - 1, 0)],
                                    dimension_numbers=('NWC', 'WIO', 'NWC'), feature_group_count=c)


def _ssm_combine(left, right):
    a1r, a1i, b1r, b1i = left
    a2r, a2i, b2r, b2i = right
    return (a2r * a1r - a2i * a1i, a2r * a1i + a2i * a1r,
            a2r * b1r - a2i * b1i + b2r, a2r * b1i + a2i * b1r + b2i)


def ssm_branch(u, a_re, a_im, log_dt, b_re, b_im, c_re, c_im, d_skip, w_glu):
    f32 = jnp.float32
    bsz, s, w = u.shape
    uf = u.astype(f32)
    ug = uf.reshape(bsz, s, SSM_GROUPS, SSM_GROUP)
    ar, ai = a_re.astype(f32), a_im.astype(f32)
    dt = jnp.exp(log_dt.astype(f32))[:, None]
    decay = jnp.exp(dt * ar)
    abar_r, abar_i = decay * jnp.cos(dt * ai), decay * jnp.sin(dt * ai)
    den = ar * ar + ai * ai
    nr, ni = abar_r - 1.0, abar_i
    fr, fi = (nr * ar + ni * ai) / den, (ni * ar - nr * ai) / den
    br, bi = b_re.astype(f32), b_im.astype(f32)
    bbar_r = fr[..., None] * br - fi[..., None] * bi
    bbar_i = fr[..., None] * bi + fi[..., None] * br
    bu_r = jnp.einsum('bsgh,gph->bsgp', ug, bbar_r)
    bu_i = jnp.einsum('bsgh,gph->bsgp', ug, bbar_i)
    a_seq_r = jnp.broadcast_to(abar_r, (1, s, SSM_GROUPS, SSM_STATE))
    a_seq_i = jnp.broadcast_to(abar_i, (1, s, SSM_GROUPS, SSM_STATE))
    _, _, st_r, st_i = lax.associative_scan(_ssm_combine, (a_seq_r, a_seq_i, bu_r, bu_i), axis=1)
    y = (jnp.einsum('bsgp,ghp->bsgh', st_r, c_re.astype(f32))
         - jnp.einsum('bsgp,ghp->bsgh', st_i, c_im.astype(f32)))
    y = y.reshape(bsz, s, w) + d_skip.astype(f32) * uf
    yg = jax.nn.gelu(y)
    out = yg * jax.nn.sigmoid(yg @ w_glu.astype(f32))
    return out.astype(u.dtype)


def mlstm_branch(q, k, v, o_pre, i_pre, f_pre, i_bias, f_bias, head_gain):
    f32 = jnp.float32
    bsz, s, w = q.shape
    nh, dh, lc = MLSTM_HEADS, MLSTM_HEAD_DIM, MLSTM_CHUNK
    nc = s // lc

    def heads(t):
        return t.astype(f32).reshape(bsz, nc, lc, nh, dh).transpose(0, 3, 1, 2, 4)

    def gates(t, bias):
        return (t.astype(f32) + bias.astype(f32)).reshape(bsz, nc, lc, nh).transpose(0, 3, 1, 2)

    qh, kh, vh = heads(q), heads(k) * (dh ** -0.5), heads(v)
    ig = gates(i_pre, i_bias)
    lf = jax.nn.log_sigmoid(gates(f_pre, f_bias))
    bcum = jnp.cumsum(lf, axis=-1)
    gtot = bcum[..., -1]

    causal = jnp.tril(jnp.ones((lc, lc), dtype=bool))
    log_d = jnp.where(causal, bcum[..., :, None] - bcum[..., None, :] + ig[..., None, :], -jnp.inf)
    m_intra = jnp.max(log_d, axis=-1)

    log_w = gtot[..., None] - bcum + ig
    m_loc = jnp.max(log_w, axis=-1)
    wgt = jnp.exp(log_w - m_loc[..., None])
    d_c = jnp.einsum('bhcsv,bhcsk->bhcvk', wgt[..., None] * vh, kh)
    d_n = jnp.einsum('bhcs,bhcsk->bhck', wgt, kh)

    def step(carry, xs):
        c_st, n_st, m_st = carry
        dc, dn, g, ml = xs
        m_new = jnp.maximum(g + m_st, ml)
        a = jnp.exp(g + m_st - m_new)
        bb = jnp.exp(ml - m_new)
        c_new = a[..., None, None] * c_st + bb[..., None, None] * dc
        n_new = a[..., None] * n_st + bb[..., None] * dn
        return (c_new, n_new, m_new), (c_st, n_st, m_st)

    init = (jnp.zeros((bsz, nh, dh, dh), f32), jnp.zeros((bsz, nh, dh), f32), jnp.zeros((bsz, nh), f32))
    xs = (jnp.moveaxis(d_c, 2, 0), jnp.moveaxis(d_n, 2, 0), jnp.moveaxis(gtot, 2, 0), jnp.moveaxis(m_loc, 2, 0))
    _, (c_prev, n_prev, m_prev) = lax.scan(step, init, xs)
    c_prev = jnp.moveaxis(c_prev, 0, 2)
    n_prev = jnp.moveaxis(n_prev, 0, 2)
    m_prev = jnp.moveaxis(m_prev, 0, 2)

    log_inter = bcum + m_prev[..., None]
    m_q = jnp.maximum(log_inter, m_intra)
    s_mat = jnp.einsum('bhcjd,bhcsd->bhcjs', qh, kh) * jnp.exp(log_d - m_q[..., None])
    inter = jnp.exp(log_inter - m_q)
    num = (jnp.einsum('bhcjs,bhcsv->bhcjv', s_mat, vh)
           + inter[..., None] * jnp.einsum('bhcvk,bhcjk->bhcjv', c_prev, qh))
    den = jnp.sum(s_mat, axis=-1) + inter * jnp.einsum('bhck,bhcjk->bhcj', n_prev, qh)
    h = num / jnp.maximum(jnp.abs(den), jnp.exp(-m_q))[..., None]
    h = h * lax.rsqrt(jnp.mean(h * h, axis=-1, keepdims=True) + RMS_EPS)
    h = h.transpose(0, 2, 3, 1, 4).reshape(bsz, s, w) * head_gain.astype(f32)
    out = jax.nn.sigmoid(o_pre.astype(f32)) * h
    return out.astype(q.dtype)


def t5_bucket(dist):
    max_exact = REL_BUCKETS // 2
    is_small = dist < max_exact
    large = max_exact + (jnp.log(jnp.maximum(dist, 1).astype(jnp.float32) / max_exact)
                         / math.log(REL_MAX_DIST / max_exact) * (REL_BUCKETS - max_exact)).astype(jnp.int32)
    large = jnp.minimum(large, REL_BUCKETS - 1)
    return jnp.where(is_small, dist, large)


def moba_branch(q, k, v, rel_bias):
    f32 = jnp.float32
    bsz, s, w = q.shape
    nh, dh, bs, qb = MOBA_HEADS, MOBA_HEAD_DIM, MOBA_BLOCK, MOBA_QUERY_BLOCK
    nb = -(-s // bs)
    s_pad = nb * bs
    topk = min(MOBA_TOPK, nb)
    nq = s // qb
    scale = dh ** -0.5

    def heads(t):
        return t.reshape(bsz, s, nh, dh).transpose(0, 2, 1, 3)

    pad = ((0, 0), (0, 0), (0, s_pad - s), (0, 0))
    kb = jnp.pad(heads(k), pad).reshape(bsz, nh, nb, bs, dh)
    vb = jnp.pad(heads(v), pad).reshape(bsz, nh, nb, bs, dh)
    k_mean = jnp.mean(kb.astype(f32), axis=3)
    q_blocks = heads(q).reshape(bsz, nh, nq, qb, dh).transpose(2, 0, 1, 3, 4)
    bias_tab = rel_bias.astype(f32)
    b_idx = jnp.arange(bsz)[:, None, None, None]
    h_idx = jnp.arange(nh)[None, :, None, None]
    blk_pos = jnp.arange(bs)

    def attend(args):
        qi, q_blk = args
        q_pos = qi * qb + jnp.arange(qb)
        cur = (qi * qb) // bs
        gate = jnp.einsum('bhqd,bhnd->bhqn', q_blk.astype(f32), k_mean)
        gate = jnp.where(jnp.arange(nb) < cur, gate, NEG_INF)
        _, sel = lax.top_k(gate, topk)
        sel_valid = (jnp.arange(topk) < cur)[:, None]
        k_sel = kb[b_idx, h_idx, sel]
        v_sel = vb[b_idx, h_idx, sel]
        lg_sel = jnp.einsum('bhqd,bhqjkd->bhqjk', q_blk, k_sel).astype(f32) * scale
        dist_sel = q_pos[None, None, :, None, None] - (sel[..., None] * bs + blk_pos)
        bias_sel = bias_tab[h_idx[..., None], t5_bucket(jnp.maximum(dist_sel, 0))]
        lg_sel = jnp.where(sel_valid, lg_sel + bias_sel, NEG_INF)
        k_own = lax.dynamic_slice_in_dim(kb, cur, 1, axis=2)[:, :, 0]
        v_own = lax.dynamic_slice_in_dim(vb, cur, 1, axis=2)[:, :, 0]
        lg_own = jnp.einsum('bhqd,bhkd->bhqk', q_blk, k_own).astype(f32) * scale
        dist_own = q_pos[:, None] - (cur * bs + blk_pos)[None, :]
        bias_own = bias_tab[:, t5_bucket(jnp.maximum(dist_own, 0))]
        lg_own = jnp.where(dist_own >= 0, lg_own + bias_own[None], NEG_INF)
        logits = jnp.concatenate([lg_sel.reshape(bsz, nh, qb, topk * bs), lg_own], axis=-1)
        p = jax.nn.softmax(logits, axis=-1).astype(v.dtype)
        p_sel = p[..., :topk * bs].reshape(bsz, nh, qb, topk, bs)
        p_own = p[..., topk * bs:]
        return (jnp.einsum('bhqjk,bhqjkd->bhqd', p_sel, v_sel)
                + jnp.einsum('bhqk,bhkd->bhqd', p_own, v_own))

    outs = lax.map(attend, (jnp.arange(nq), q_blocks))
    return outs.transpose(1, 0, 3, 2, 4).reshape(bsz, s, w).astype(q.dtype)


def setup_inputs(seed: int = 0) -> dict:
    key = jax.random.key(seed)
    ks = jax.random.split(key, 32)
    f32 = jnp.float32
    nrm = lambda k, shape, sc: jax.random.normal(k, shape, f32) * sc
    gain = lambda k: 1.0 + 0.02 * jax.random.normal(k, (DEPTH, D_MODEL), f32)
    n_idx = jnp.arange(SSM_STATE, dtype=f32)
    return {
        "x": jax.random.normal(ks[0], (BATCH, SEQ, D_MODEL), f32),
        "w_in": nrm(ks[1], (DEPTH, D_MODEL, IN_COLS), D_MODEL ** -0.5),
        "conv_w": nrm(ks[2], (DEPTH, CONV_WIDTH, 2 * MLSTM_WIDTH), CONV_WIDTH ** -0.5),
        "ssm_a_re": -0.5 + 0.01 * jax.random.normal(ks[3], (DEPTH, SSM_GROUPS, SSM_STATE), f32),
        "ssm_a_im": math.pi * n_idx + 0.01 * jax.random.normal(ks[4], (DEPTH, SSM_GROUPS, SSM_STATE), f32),
        "ssm_log_dt": jax.random.uniform(ks[5], (DEPTH, SSM_GROUPS), f32, math.log(SSM_DT_MIN), math.log(SSM_DT_MAX)),
        "ssm_b_re": nrm(ks[6], (DEPTH, SSM_GROUPS, SSM_STATE, SSM_GROUP), (2 * SSM_GROUP) ** -0.5),
        "ssm_b_im": nrm(ks[7], (DEPTH, SSM_GROUPS, SSM_STATE, SSM_GROUP), (2 * SSM_GROUP) ** -0.5),
        "ssm_c_re": nrm(ks[8], (DEPTH, SSM_GROUPS, SSM_GROUP, SSM_STATE), (2 * SSM_STATE) ** -0.5),
        "ssm_c_im": nrm(ks[9], (DEPTH, SSM_GROUPS, SSM_GROUP, SSM_STATE), (2 * SSM_STATE) ** -0.5),
        "ssm_d": nrm(ks[10], (DEPTH, SSM_WIDTH), 1.0),
        "ssm_w_glu": nrm(ks[11], (DEPTH, SSM_WIDTH, SSM_WIDTH), SSM_WIDTH ** -0.5),
        "mlstm_i_bias": nrm(ks[12], (DEPTH, MLSTM_HEADS), 0.1),
        "mlstm_f_bias": jnp.linspace(3.0, 6.0, MLSTM_HEADS, dtype=f32)[None, :] + nrm(ks[13], (DEPTH, MLSTM_HEADS), 0.1),
        "mlstm_head_gain": 1.0 + 0.02 * jax.random.normal(ks[14], (DEPTH, MLSTM_WIDTH), f32),
        "rel_bias": nrm(ks[15], (MOBA_HEADS, REL_BUCKETS), 0.5),
        "w_ssm_proj": nrm(ks[16], (DEPTH, SSM_WIDTH, D_MODEL), SSM_WIDTH ** -0.5),
        "w_mlstm_proj": nrm(ks[17], (DEPTH, MLSTM_WIDTH, D_MODEL), MLSTM_WIDTH ** -0.5),
        "w_moba_proj": nrm(ks[18], (DEPTH, MOBA_WIDTH, D_MODEL), MOBA_WIDTH ** -0.5),
        "w_out": nrm(ks[19], (DEPTH, D_MODEL, D_MODEL), D_MODEL ** -0.5),
        "w_ff1": nrm(ks[20], (DEPTH, D_MODEL, D_FF), D_MODEL ** -0.5),
        "w_ff2": nrm(ks[21], (DEPTH, D_FF, D_MODEL), D_FF ** -0.5),
        "norm_mix_pre": gain(ks[22]),
        "norm_mix_post": gain(ks[23]),
        "norm_ffn_pre": gain(ks[24]),
        "norm_ffn_post": gain(ks[25]),
    }


def reference(x, w_in, conv_w, ssm_a_re, ssm_a_im, ssm_log_dt, ssm_b_re, ssm_b_im, ssm_c_re, ssm_c_im,
              ssm_d, ssm_w_glu, mlstm_i_bias, mlstm_f_bias, mlstm_head_gain, rel_bias,
              w_ssm_proj, w_mlstm_proj, w_moba_proj, w_out, w_ff1, w_ff2,
              norm_mix_pre, norm_mix_post, norm_ffn_pre, norm_ffn_post):
    bsz, s, _ = x.shape
    for l in range(DEPTH):
        h = rms_norm(x, norm_mix_pre[l])
        proj = jnp.einsum('bsd,dc->bsc', h, w_in[l])
        (u_ssm, m_q, m_k, m_v, m_o, m_i, m_f, a_q, a_k, a_v, gate_pre) = split_cols(proj, IN_SIZES)
        qk = jax.nn.silu(causal_conv(jnp.concatenate([m_q, m_k], axis=-1), conv_w[l]))
        m_q, m_k = qk[..., :MLSTM_WIDTH], qk[..., MLSTM_WIDTH:]
        y_ssm = ssm_branch(u_ssm, ssm_a_re[l], ssm_a_im[l], ssm_log_dt[l], ssm_b_re[l], ssm_b_im[l],
                           ssm_c_re[l], ssm_c_im[l], ssm_d[l], ssm_w_glu[l])
        y_mlstm = mlstm_branch(m_q, m_k, m_v, m_o, m_i, m_f, mlstm_i_bias[l], mlstm_f_bias[l], mlstm_head_gain[l])
        y_moba = moba_branch(a_q, a_k, a_v, rel_bias)
        g = jax.nn.sigmoid(gate_pre.astype(jnp.float32)).astype(x.dtype).reshape(bsz, s, N_BRANCHES, D_MODEL)
        merged = (g[:, :, 0] * (y_ssm @ w_ssm_proj[l])
                  + g[:, :, 1] * (y_mlstm @ w_mlstm_proj[l])
                  + g[:, :, 2] * (y_moba @ w_moba_proj[l]))
        x = x + rms_norm(merged @ w_out[l], norm_mix_post[l])
        h = rms_norm(x, norm_ffn_pre[l])
        f = jnp.square(jax.nn.relu(h @ w_ff1[l])) @ w_ff2[l]
        x = x + rms_norm(f, norm_ffn_post[l])
    return x
```

```cpp
#include <hip/hip_runtime.h>
#include <cstdio>
#include <cstdint>

#ifndef MK_ONE_LAUNCH
#define MK_ONE_LAUNCH 1
#endif

namespace pg8 {
#define PG8_LAS __attribute__((address_space(3)))
typedef unsigned short bf16_t;
typedef short bf16x8 __attribute__((ext_vector_type(8)));
typedef float f32x4 __attribute__((ext_vector_type(4)));
typedef unsigned u32x4 __attribute__((ext_vector_type(4)));
constexpr int BM = 256, BK = 64, HALF = 128, HTB = HALF * BK * 2, STAGE_BYTES = 8 * HTB, NXCD = 8, WGM = 8;

__host__ __device__ __forceinline__ int lds_byte(int r, int c) { const int st = (r >> 4) * 2 + (c >> 5), rr = r & 15, cc = c & 31, ob = rr * 64 + cc * 2; return st * 1024 + (ob ^ (((ob >> 9) & 1) << 5)); }
__host__ __device__ __forceinline__ void stage_rc(int b, int& R, int& C) { const int st = b / 1024, sb = b % 1024, swz = sb ^ (((sb >> 9) & 1) << 5); R = (st >> 1) * 16 + swz / 64; C = (st & 1) * 32 + (swz % 64) / 2; }
__host__ __device__ __forceinline__ int perm32(int rho) { const int n = rho >> 4, i = rho & 15; return 8 * (i >> 2) + 4 * n + (i & 3); }

struct Unit { int pm, pn; };
struct Gemm { const bf16_t* A; const bf16_t* Bt; int M, N, K, lda, ldb; };

struct StaticOrder {
    int nM, nN, nwg, G, c;
    __host__ __device__ void init(int M, int N, int G_, int c_) { nM = M / BM; nN = N / BM; nwg = nM * nN; G = G_; c = c_; }
    __host__ __device__ bool next(int i, Unit& u) const {
        const long L = (long)i * G + c; if (L >= nwg) return false;
        int wgid = (int)L; { const int q = nwg / NXCD, r = nwg % NXCD, xcd = wgid % NXCD, off = wgid / NXCD; wgid = (xcd < r ? xcd * (q + 1) : r * (q + 1) + (xcd - r) * q) + off; }
        const int nig = WGM * nN, gid = wgid / nig, fm = gid * WGM, gsz = (nM - fm) < WGM ? (nM - fm) : WGM;
        u.pm = fm + ((wgid % nig) % gsz); u.pn = (wgid % nig) / gsz; return true;
    }
    __device__ __forceinline__ void a_ready(const Unit&) const {}
    __device__ __forceinline__ void done(const Unit&) const {}
};

typedef float f32x2_t __attribute__((ext_vector_type(2))); typedef __bf16 bf16x2_t __attribute__((ext_vector_type(2)));
__device__ __forceinline__ unsigned cvt_pk_bf16(float lo, float hi) { f32x2_t v = {lo, hi}; bf16x2_t b = __builtin_convertvector(v, bf16x2_t); return __builtin_bit_cast(unsigned, b); }
__device__ __forceinline__ float bflo(unsigned w) { return __uint_as_float(w << 16); }
__device__ __forceinline__ float bfhi(unsigned w) { return __uint_as_float(w & 0xffff0000u); }
__device__ __forceinline__ float sigmoidf_(float x) { return 1.0f / (1.0f + __expf(-x)); }

struct EpiProj {
    static constexpr bool PERM = true, AFTER_DRAIN = false;
    bf16_t* O; int ldc; const float* rstd; int gate_pn;
    __device__ __forceinline__ void operator()(const f32x4 (&acc)[2][2][4][2], const Unit& u, int wr, int wc, int fr, int fq) const {
        const int row0 = u.pm * BM + wr * 64 + fr; const int col0 = u.pn * BM + wc * 32 + 8 * fq; const bool sg = u.pn >= gate_pn;
#pragma unroll
        for (int ai = 0; ai < 2; ++ai)
#pragma unroll
            for (int m = 0; m < 4; ++m) { const int row = row0 + ai * HALF + m * 16; const float rs = rstd[row]; bf16_t* rowp = O + (size_t)row * ldc + col0;
#pragma unroll
                for (int bj = 0; bj < 2; ++bj) { f32x4 v0 = acc[ai][bj][m][0] * rs, v1 = acc[ai][bj][m][1] * rs;
                    if (sg) {
#pragma unroll
                        for (int j = 0; j < 4; ++j) { v0[j] = sigmoidf_(v0[j]); v1[j] = sigmoidf_(v1[j]); } }
                    u32x4 w; w.x = cvt_pk_bf16(v0[0], v0[1]); w.y = cvt_pk_bf16(v0[2], v0[3]); w.z = cvt_pk_bf16(v1[0], v1[1]); w.w = cvt_pk_bf16(v1[2], v1[3]);
                    *(u32x4*)(rowp + bj * HALF) = w; } }
    }
};
struct EpiGlu {
    static constexpr bool PERM = true, AFTER_DRAIN = false;
    const bf16_t* Yg; bf16_t* O; int ld;
    __device__ __forceinline__ void operator()(const f32x4 (&acc)[2][2][4][2], const Unit& u, int wr, int wc, int fr, int fq) const {
        const int row0 = u.pm * BM + wr * 64 + fr; const int col0 = u.pn * BM + wc * 32 + 8 * fq;
#pragma unroll
        for (int ai = 0; ai < 2; ++ai)
#pragma unroll
            for (int m = 0; m < 4; ++m) { const size_t ro = (size_t)(row0 + ai * HALF + m * 16) * ld + col0;
#pragma unroll
                for (int bj = 0; bj < 2; ++bj) { const f32x4 v0 = acc[ai][bj][m][0], v1 = acc[ai][bj][m][1];
                    const u32x4 y = *(const u32x4*)(Yg + ro + bj * HALF);
                    u32x4 w;
                    w.x = cvt_pk_bf16(bflo(y.x) * sigmoidf_(v0[0]), bfhi(y.x) * sigmoidf_(v0[1]));
                    w.y = cvt_pk_bf16(bflo(y.y) * sigmoidf_(v0[2]), bfhi(y.y) * sigmoidf_(v0[3]));
                    w.z = cvt_pk_bf16(bflo(y.z) * sigmoidf_(v1[0]), bfhi(y.z) * sigmoidf_(v1[1]));
                    w.w = cvt_pk_bf16(bflo(y.w) * sigmoidf_(v1[2]), bfhi(y.w) * sigmoidf_(v1[3]));
                    *(u32x4*)(O + ro + bj * HALF) = w; } }
    }
};
template <int FIRST> struct EpiBranch {
    static constexpr bool PERM = true, AFTER_DRAIN = false;
    const bf16_t* Gt; int ldg; bf16_t* Mg; int ldm;
    __device__ __forceinline__ void operator()(const f32x4 (&acc)[2][2][4][2], const Unit& u, int wr, int wc, int fr, int fq) const {
        const int row0 = u.pm * BM + wr * 64 + fr; const int col0 = u.pn * BM + wc * 32 + 8 * fq;
#pragma unroll
        for (int ai = 0; ai < 2; ++ai)
#pragma unroll
            for (int m = 0; m < 4; ++m) { const int row = row0 + ai * HALF + m * 16;
#pragma unroll
                for (int bj = 0; bj < 2; ++bj) { const f32x4 v0 = acc[ai][bj][m][0], v1 = acc[ai][bj][m][1];
                    const u32x4 g = *(const u32x4*)(Gt + (size_t)row * ldg + col0 + bj * HALF);
                    float o[8] = { bflo(g.x) * v0[0], bfhi(g.x) * v0[1], bflo(g.y) * v0[2], bfhi(g.y) * v0[3], bflo(g.z) * v1[0], bfhi(g.z) * v1[1], bflo(g.w) * v1[2], bfhi(g.w) * v1[3] };
                    bf16_t* mp = Mg + (size_t)row * ldm + col0 + bj * HALF;
                    if (!FIRST) { const u32x4 p = *(const u32x4*)mp; o[0] += bflo(p.x); o[1] += bfhi(p.x); o[2] += bflo(p.y); o[3] += bfhi(p.y); o[4] += bflo(p.z); o[5] += bfhi(p.z); o[6] += bflo(p.w); o[7] += bfhi(p.w); }
                    u32x4 w; w.x = cvt_pk_bf16(o[0], o[1]); w.y = cvt_pk_bf16(o[2], o[3]); w.z = cvt_pk_bf16(o[4], o[5]); w.w = cvt_pk_bf16(o[6], o[7]);
                    *(u32x4*)mp = w; } }
    }
};
struct EpiF32 {
    static constexpr bool PERM = false, AFTER_DRAIN = false;
    float* C; int ldc;
    __device__ __forceinline__ void operator()(const f32x4 (&acc)[2][2][4][2], const Unit& u, int wr, int wc, int fr, int fq) const {
        const int row0 = u.pm * BM + wr * 64 + fr, col0 = u.pn * BM + wc * 32 + 4 * fq;
#pragma unroll
        for (int ai = 0; ai < 2; ++ai)
#pragma unroll
            for (int m = 0; m < 4; ++m) { float* rowp = C + (size_t)(row0 + ai * HALF + m * 16) * ldc + col0;
#pragma unroll
                for (int bj = 0; bj < 2; ++bj)
#pragma unroll
                    for (int n = 0; n < 2; ++n) *(f32x4*)(rowp + bj * HALF + n * 16) = acc[ai][bj][m][n]; }
    }
};
struct EpiFF1 {
    static constexpr bool PERM = true, AFTER_DRAIN = false;
    bf16_t* O; int ldc; const float* rstd;
    __device__ __forceinline__ void operator()(const f32x4 (&acc)[2][2][4][2], const Unit& u, int wr, int wc, int fr, int fq) const {
        const int row0 = u.pm * BM + wr * 64 + fr; const int col0 = u.pn * BM + wc * 32 + 8 * fq;
#pragma unroll
        for (int ai = 0; ai < 2; ++ai)
#pragma unroll
            for (int m = 0; m < 4; ++m) { const int row = row0 + ai * HALF + m * 16; const float rs = rstd[row]; bf16_t* rowp = O + (size_t)row * ldc + col0;
#pragma unroll
                for (int bj = 0; bj < 2; ++bj) { f32x4 v0 = acc[ai][bj][m][0] * rs, v1 = acc[ai][bj][m][1] * rs;
#pragma unroll
                    for (int j = 0; j < 4; ++j) { const float a = fmaxf(v0[j], 0.f), b = fmaxf(v1[j], 0.f); v0[j] = a * a; v1[j] = b * b; }
                    u32x4 w; w.x = cvt_pk_bf16(v0[0], v0[1]); w.y = cvt_pk_bf16(v0[2], v0[3]); w.z = cvt_pk_bf16(v1[0], v1[1]); w.w = cvt_pk_bf16(v1[2], v1[3]);
                    *(u32x4*)(rowp + bj * HALF) = w; } }
    }
};

template <class Epi, class Sched, bool ALIGN_EPI = false, bool SP2 = false>
__device__ __forceinline__ void gemm_phase(PG8_LAS unsigned char* lds, const Gemm g, const Sched& S, const Epi& E) {
    int tid_ = threadIdx.x; asm volatile("" : "+v"(tid_));
    const int tid = tid_, wid = __builtin_amdgcn_readfirstlane(tid >> 6), lane = tid & 63, wr = wid >> 2, wc = wid & 3, fr = lane & 15, fq = lane >> 4;
    const int K = g.K, nt = K / BK;
    unsigned voffA[2], voffB[2];
#pragma unroll
    for (int i = 0; i < 2; ++i) { int R, C; stage_rc(tid * 16 + i * 8192, R, C); const int Rb = Epi::PERM ? ((R & ~31) + perm32(R & 31)) : R;
        voffA[i] = (unsigned)(R * g.lda + C) * 2u; voffB[i] = (unsigned)(Rb * g.ldb + C) * 2u; }
    const size_t kstep = (size_t)(BK * 2);
    const size_t hstepA = (size_t)HALF * g.lda * 2, hstepB = (size_t)HALF * g.ldb * 2;
    const size_t tstepA = 2 * hstepA, tstepB = 2 * hstepB;
    const unsigned ldsw = (unsigned)wid * 1024u;
    const int aoff = lds_byte(wr * 64 + fr, fq * 8), boff = lds_byte(wc * 32 + fr, fq * 8);
#define PG8_SA(b, h) (((b) * 2 + (h)) * HTB)
#define PG8_SB(b, h) ((4 + (b) * 2 + (h)) * HTB)
#define PG8_STAGE(bufoff, gbase, voff) do { _Pragma("unroll") for (int _i = 0; _i < 2; ++_i) \
        __builtin_amdgcn_global_load_lds((const unsigned*)((const char*)(gbase) + (voff)[_i]), (PG8_LAS unsigned*)(lds + (bufoff) + ldsw + _i * 8192), 16, 0, 0); } while (0)
#define PG8_LDA(dst, b, h) do { _Pragma("unroll") for (int m = 0; m < 4; ++m) _Pragma("unroll") for (int k = 0; k < 2; ++k) dst[m][k] = *(const PG8_LAS bf16x8*)(lds + PG8_SA(b, h) + aoff + m * 2048 + k * 1024); } while (0)
#define PG8_LDB(dst, b, h) do { _Pragma("unroll") for (int n = 0; n < 2; ++n) _Pragma("unroll") for (int k = 0; k < 2; ++k) dst[n][k] = *(const PG8_LAS bf16x8*)(lds + PG8_SB(b, h) + boff + n * 2048 + k * 1024); } while (0)
#define PG8_MMA(ai, bj, At, Bt) do { __builtin_amdgcn_s_setprio(1); _Pragma("unroll") for (int m = 0; m < 4; ++m) _Pragma("unroll") for (int n = 0; n < 2; ++n) _Pragma("unroll") for (int k = 0; k < 2; ++k) \
        acc[ai][bj][m][n] = __builtin_amdgcn_mfma_f32_16x16x32_bf16(Bt[n][k], At[m][k], acc[ai][bj][m][n], 0, 0, 0); __builtin_amdgcn_s_setprio(0); } while (0)
#define PG8_WAIT_V(n) asm volatile("s_waitcnt vmcnt(" #n ")" ::: "memory")
#define PG8_WAIT_L(n) asm volatile("s_waitcnt lgkmcnt(" #n ")" ::: "memory")
#define PG8_BAR __builtin_amdgcn_s_barrier()
#define PG8_SCHED __builtin_amdgcn_sched_barrier(0)
    Unit cur, nxt; int ui = 0;
    if (!S.next(0, cur)) return;
    f32x4 acc[2][2][4][2];
#pragma unroll
    for (int a = 0; a < 2; ++a)
#pragma unroll
        for (int b = 0; b < 2; ++b)
#pragma unroll
            for (int m = 0; m < 4; ++m)
#pragma unroll
                for (int n = 0; n < 2; ++n) acc[a][b][m][n] = (f32x4){0.f, 0.f, 0.f, 0.f};
    bf16x8 At[4][2], B0[2][2], B1[2][2];
    const char* cA = (const char*)g.A + (size_t)cur.pm * tstepA; const char* cB = (const char*)g.Bt + (size_t)cur.pn * tstepB;
    S.a_ready(cur);
    if constexpr (SP2) {
        PG8_STAGE(PG8_SB(0, 0), cB, voffB); PG8_STAGE(PG8_SB(0, 1), cB + hstepB, voffB); PG8_STAGE(PG8_SA(0, 0), cA, voffA); PG8_STAGE(PG8_SA(0, 1), cA + hstepA, voffA);
        if (wr == 1) PG8_BAR;
        PG8_WAIT_V(2); PG8_BAR;
        PG8_STAGE(PG8_SB(1, 0), cB + kstep, voffB); PG8_STAGE(PG8_SA(1, 0), cA + kstep, voffA); PG8_STAGE(PG8_SB(1, 1), cB + hstepB + kstep, voffB);
        PG8_WAIT_V(6); PG8_BAR;
    } else {
        PG8_STAGE(PG8_SB(0, 0), cB, voffB); PG8_STAGE(PG8_SA(0, 0), cA, voffA); PG8_STAGE(PG8_SB(0, 1), cB + hstepB, voffB); PG8_STAGE(PG8_SA(0, 1), cA + hstepA, voffA);
        if (wr == 1) PG8_BAR;
        PG8_WAIT_V(4); PG8_BAR;
        PG8_STAGE(PG8_SB(1, 0), cB + kstep, voffB); PG8_STAGE(PG8_SA(1, 0), cA + kstep, voffA); PG8_STAGE(PG8_SB(1, 1), cB + hstepB + kstep, voffB);
        PG8_WAIT_V(6); PG8_BAR;
    }
    for (;;) {
        const bool has_next = S.next(ui + 1, nxt);
        const char* nA = has_next ? (const char*)g.A + (size_t)nxt.pm * tstepA : cA; const char* nB = has_next ? (const char*)g.Bt + (size_t)nxt.pn * tstepB : cB;
        for (int t = 0; t < nt; t += 2) {
            const bool last = (t == nt - 2);
            const char* a1 = cA + (size_t)(t + 1) * kstep;
            const char* a2 = last ? nA : cA + (size_t)(t + 2) * kstep; const char* b2 = last ? nB : cB + (size_t)(t + 2) * kstep;
            const char* a3 = a2 + kstep; const char* b3 = b2 + kstep;
            if (last && has_next) S.a_ready(nxt);
            if constexpr (SP2) {
            PG8_LDB(B0, 0, 0); PG8_LDB(B1, 0, 1); PG8_SCHED; PG8_LDA(At, 0, 0); PG8_STAGE(PG8_SA(1, 1), a1 + hstepA, voffA);
            PG8_WAIT_V(8); PG8_WAIT_L(0); PG8_BAR; PG8_MMA(0, 0, At, B0); PG8_MMA(0, 1, At, B1); PG8_BAR; PG8_SCHED;
            PG8_LDA(At, 0, 1); PG8_STAGE(PG8_SB(0, 0), b2, voffB); PG8_STAGE(PG8_SB(0, 1), b2 + hstepB, voffB); PG8_STAGE(PG8_SA(0, 0), a2, voffA);
            PG8_WAIT_V(8); PG8_WAIT_L(0); PG8_BAR; PG8_MMA(1, 0, At, B0); PG8_MMA(1, 1, At, B1); PG8_BAR; PG8_SCHED;
            PG8_LDB(B0, 1, 0); PG8_LDB(B1, 1, 1); PG8_SCHED; PG8_LDA(At, 1, 0); PG8_STAGE(PG8_SA(0, 1), a2 + hstepA, voffA);
            PG8_WAIT_V(8); PG8_WAIT_L(0); PG8_BAR; PG8_MMA(0, 0, At, B0); PG8_MMA(0, 1, At, B1); PG8_BAR; PG8_SCHED;
            PG8_LDA(At, 1, 1); PG8_STAGE(PG8_SB(1, 0), b3, voffB); PG8_STAGE(PG8_SB(1, 1), b3 + hstepB, voffB); PG8_STAGE(PG8_SA(1, 0), a3, voffA);
            PG8_WAIT_V(8); PG8_WAIT_L(0); PG8_BAR; PG8_MMA(1, 0, At, B0); PG8_MMA(1, 1, At, B1); PG8_BAR; PG8_SCHED;
            } else {
            PG8_LDB(B0, 0, 0); PG8_SCHED; PG8_LDA(At, 0, 0); PG8_STAGE(PG8_SA(1, 1), a1 + hstepA, voffA);
            PG8_WAIT_L(8); PG8_BAR; PG8_WAIT_L(0); PG8_MMA(0, 0, At, B0); PG8_BAR; PG8_SCHED;
            PG8_LDB(B1, 0, 1); PG8_STAGE(PG8_SB(0, 0), b2, voffB);
            PG8_BAR; PG8_WAIT_L(0); PG8_MMA(0, 1, At, B1); PG8_BAR;
            PG8_LDA(At, 0, 1); PG8_STAGE(PG8_SA(0, 0), a2, voffA);
            PG8_BAR; PG8_WAIT_L(0); PG8_MMA(1, 0, At, B0); PG8_BAR; PG8_SCHED;
            PG8_STAGE(PG8_SB(0, 1), b2 + hstepB, voffB);
            PG8_WAIT_V(6); PG8_BAR; PG8_MMA(1, 1, At, B1); PG8_BAR;
            PG8_LDB(B0, 1, 0); PG8_SCHED; PG8_LDA(At, 1, 0); PG8_STAGE(PG8_SA(0, 1), a2 + hstepA, voffA);
            PG8_WAIT_L(8); PG8_BAR; PG8_WAIT_L(0); PG8_MMA(0, 0, At, B0); PG8_BAR; PG8_SCHED;
            PG8_LDB(B1, 1, 1); PG8_STAGE(PG8_SB(1, 0), b3, voffB);
            PG8_BAR; PG8_WAIT_L(0); PG8_MMA(0, 1, At, B1); PG8_BAR;
            PG8_LDA(At, 1, 1); PG8_STAGE(PG8_SA(1, 0), a3, voffA);
            PG8_BAR; PG8_WAIT_L(0); PG8_MMA(1, 0, At, B0); PG8_BAR; PG8_SCHED;
            PG8_STAGE(PG8_SB(1, 1), b3 + hstepB, voffB);
            PG8_WAIT_V(6); PG8_BAR; PG8_MMA(1, 1, At, B1); PG8_BAR;
            }
        }
        if constexpr (ALIGN_EPI) { if (wr == 0) PG8_BAR; }
        E(acc, cur, wr, wc, fr, fq); S.done(cur);
        if (!has_next) break;
#pragma unroll
        for (int a = 0; a < 2; ++a)
#pragma unroll
            for (int b = 0; b < 2; ++b)
#pragma unroll
                for (int m = 0; m < 4; ++m)
#pragma unroll
                    for (int n = 0; n < 2; ++n) acc[a][b][m][n] = (f32x4){0.f, 0.f, 0.f, 0.f};
        cur = nxt; cA = nA; cB = nB; ++ui;
        if constexpr (ALIGN_EPI) { if (wr == 1) PG8_BAR; }
    }
    PG8_WAIT_V(0);
    if constexpr (!ALIGN_EPI) { if (wr == 0) PG8_BAR; }
    PG8_BAR;
#undef PG8_SA
#undef PG8_SB
#undef PG8_STAGE
#undef PG8_LDA
#undef PG8_LDB
#undef PG8_MMA
#undef PG8_WAIT_V
#undef PG8_WAIT_L
#undef PG8_BAR
#undef PG8_SCHED
}
}

constexpr int NB = 8, SEQ = 2048, D = 1024, DEPTH = 4, M = NB * SEQ;
constexpr int NP = 7168;
constexpr int C_U = 0, C_MQ = 512, C_MK = 1024, C_MV = 1536, C_MO = 2048, C_AQ = 2560, C_AK = 3072, C_AV = 3584, C_G = 4096;
constexpr int C_YSSM = C_AK, C_YML = C_MO, C_YMOBA = C_AQ;
constexpr int FF = 4096;
constexpr float RMS_EPS = 1e-6f;
constexpr int SSM_L = 64, SSM_NC = SEQ / SSM_L;
constexpr int ML_L = 128, ML_NC = SEQ / ML_L;
constexpr int DC_ROWS = 129, DC_UNIT = 136 * 128;

constexpr size_t MiB = 1u << 20;
constexpr size_t WS_CTL = 0, CTL_ZERO_BYTES = 1 * MiB;
constexpr size_t WS_WT = 2 * MiB, WT_LAYER = 35 * MiB + MiB / 2;
constexpr size_t WT_IN = 0, WT_GLU = 14 * MiB, WT_BR = 14 * MiB + MiB / 2, WT_OUT = 17 * MiB + MiB / 2, WT_FF1 = 19 * MiB + MiB / 2, WT_FF2 = 27 * MiB + MiB / 2;
constexpr size_t WS_XB = 144 * MiB;
constexpr size_t WS_PROJ = 176 * MiB;
constexpr size_t WS_DC = 400 * MiB;
constexpr size_t WS_SLOC = 417 * MiB;
constexpr size_t WS_SMALL = 421 * MiB;
constexpr size_t SM_RSTD = 0, SM_G8 = 64 * 1024, SM_KM = SM_G8 + 512 * 1024, SM_STATS = SM_KM + 128 * 1024, SM_MPREV = SM_STATS + 4096, SM_WG8 = SM_MPREV + 4096;
constexpr size_t WS_END = 424 * MiB;
static_assert(WS_WT + 4 * WT_LAYER <= WS_XB && WS_XB + (size_t)M * D * 2 <= WS_PROJ && WS_PROJ + (size_t)M * NP * 2 <= WS_DC && WS_DC + (size_t)512 * DC_UNIT * 2 <= WS_SLOC && WS_SLOC + 4 * MiB <= WS_SMALL && SM_WG8 + 4 * 8 * 1024 * 4 <= 3 * MiB, "ws map");
constexpr size_t PROJ_TMP1 = 0, PROJ_HFF = 0, PROJ_TMP2 = 128 * MiB;
constexpr int CW_BAR = 4096;

constexpr int NWAVES = 8;
constexpr int RING_OFF = 0, RING_BYTES = 131072;
constexpr int LDSCTL_OFF = 147456 - 512, MISC_OFF = LDSCTL_OFF + 320;
constexpr int LDS_BYTES = 147456;

#define GAS __attribute__((address_space(1)))
#define LAS __attribute__((address_space(3)))
typedef unsigned short bf16;
typedef unsigned v4u __attribute__((ext_vector_type(4)));
typedef unsigned v2u __attribute__((ext_vector_type(2)));
typedef float f32x4 __attribute__((ext_vector_type(4)));
typedef float f32x16 __attribute__((ext_vector_type(16)));
typedef short bf16x8 __attribute__((ext_vector_type(8)));
typedef short s16x4 __attribute__((ext_vector_type(4)));
typedef GAS unsigned gu32;
#define RLX_AGENT __ATOMIC_RELAXED, __HIP_MEMORY_SCOPE_AGENT
#define LDS_WAIT() asm volatile("s_waitcnt lgkmcnt(0)" ::: "memory")
__device__ __forceinline__ unsigned f2bf(float f) { unsigned u = __builtin_bit_cast(unsigned, f); return (u + 0x7fffu + ((u >> 16) & 1u)) >> 16; }
__device__ __forceinline__ unsigned pk2(float lo, float hi) { return pg8::cvt_pk_bf16(lo, hi); }
__device__ __forceinline__ float bf2f(unsigned short b) { return __uint_as_float((unsigned)b << 16); }
using pg8::bflo; using pg8::bfhi; using pg8::sigmoidf_;
__device__ __forceinline__ int crow(int r, int hi) { return (r & 3) + 8 * (r >> 2) + 4 * hi; }
#define MFMA32(a, b, c) __builtin_amdgcn_mfma_f32_32x32x16_bf16((a), (b), (c), 0, 0, 0)

#define XB_TMO      128
#define XB_XCNT(j)  (256  + 64 * (j))
#define XB_XSUB(j)  (1280 + 64 * (j))
#define XB_XGEN(j)  (2304 + 64 * (j))
#define XB_TOP      3328
#define XB_TOPGEN   3392
#define XCD_BAR_WORDS 3456
#define XB_SPIN_CAP (1u << 18)
__device__ __forceinline__ unsigned xb_ld(unsigned* p)              { return __hip_atomic_load(p, __ATOMIC_RELAXED, __HIP_MEMORY_SCOPE_AGENT); }
__device__ __forceinline__ unsigned xb_add(unsigned* p, unsigned v) { return __hip_atomic_fetch_add(p, v, __ATOMIC_RELAXED, __HIP_MEMORY_SCOPE_AGENT); }
__device__ __forceinline__ unsigned xb_xcc_id() { return (unsigned)__builtin_amdgcn_s_getreg((3 << 11) | 20) & 0xFu; }
#define XB_SPIN(cond, bar) do { unsigned _sp = 0; while (cond) { __builtin_amdgcn_s_sleep(1); \
    if ((++_sp & 255u) == 0u) { if (xb_ld(&(bar)[XB_TMO])) break; if (_sp > XB_SPIN_CAP) { atomicAdd(&(bar)[XB_TMO], 1u); break; } } } } while (0)
struct XcdBarrier { unsigned* bar; unsigned x; volatile LAS unsigned* st; };
__device__ __forceinline__ XcdBarrier xcd_barrier_post(unsigned* bar, volatile LAS unsigned* st) {
    XcdBarrier b; b.bar = bar; b.x = xb_xcc_id(); b.st = st;
    if (threadIdx.x == 0) (void)xb_add(&bar[XB_XCNT(b.x)], 1u);
    return b;
}
__device__ __forceinline__ void xcd_barrier_complete(unsigned* bar, unsigned x, unsigned& nloc, unsigned& nx) {
    const unsigned G = gridDim.x * gridDim.y * gridDim.z;
    unsigned sum, cnt, mine, sp = 0u;
    for (;;) {
        sum = 0u; cnt = 0u; mine = 0u;
#pragma unroll
        for (unsigned j = 0; j < 16; ++j) { const unsigned c = xb_ld(&bar[XB_XCNT(j)]); sum += c; cnt += (c > 0u) ? 1u : 0u; mine = (j == x) ? c : mine; }
        if (sum == G) break;
        __builtin_amdgcn_s_sleep(1);
        if ((++sp & 255u) == 0u) { if (xb_ld(&bar[XB_TMO])) break; if (sp > XB_SPIN_CAP) { atomicAdd(&bar[XB_TMO], 1u); break; } }
    }
    nloc = mine > 0u ? mine : 1u; nx = cnt > 0u ? cnt : 1u;
}
__device__ __forceinline__ void xcd_barrier(const XcdBarrier& b) {
    asm volatile("s_waitcnt vmcnt(0)" ::: "memory");
    __syncthreads();
    if (threadIdx.x == 0) {
        unsigned* bar = b.bar;
        __builtin_amdgcn_s_waitcnt(0);
        unsigned nloc = b.st[0], nx = b.st[1];
        if (nloc == 0u) { xcd_barrier_complete(bar, b.x, nloc, nx); b.st[0] = nloc; b.st[1] = nx; }
        const unsigned old = xb_add(&bar[XB_XSUB(b.x)], 1u);
        const unsigned gen = old / nloc;
        if (old + 1u == (gen + 1u) * nloc) {
            __builtin_amdgcn_fence(__ATOMIC_RELEASE, "agent");
            asm volatile("s_waitcnt vmcnt(0)" ::: "memory");
            const unsigned og = xb_add(&bar[XB_TOP], 1u);
            const unsigned tg = og / nx;
            if (og + 1u == (tg + 1u) * nx) xb_add(&bar[XB_TOPGEN], 1u);
            else XB_SPIN(xb_ld(&bar[XB_TOPGEN]) == tg, bar);
            __builtin_amdgcn_fence(__ATOMIC_ACQUIRE, "agent");
            xb_add(&bar[XB_XGEN(b.x)], 1u);
            asm volatile("s_waitcnt vmcnt(0)" ::: "memory");
        } else {
            XB_SPIN(xb_ld(&bar[XB_XGEN(b.x)]) == gen, bar);
            __builtin_amdgcn_fence(__ATOMIC_ACQUIRE, "agent");
            asm volatile("s_waitcnt vmcnt(0)" ::: "memory");
        }
    }
    __syncthreads();
}

struct Args { const float* in[26]; float* out; unsigned char* ws; int s_lo, s_hi; };
struct Frame {
    LAS unsigned char* lds;
    int tid, lane, wave, G, wg;
    const float* const* in; float* out; unsigned char* ws;
    bf16* XB; bf16* PROJ; bf16* DC; float* SLOC; float* RSTD; float* G8; float* KM; float* STATS; float* MPREV; float* WG8;
};
__device__ __forceinline__ float wave_sum(float v) {
#pragma unroll
    for (int o = 1; o < 64; o <<= 1) v += __shfl_xor(v, o);
    return v;
}

__device__ __forceinline__ void transpose_item(const float* W, int spitch, int scol, bf16* WT, int dpitch, int dk0, const float* gain, LAS float* scr, int kb, int nb, int lane) {
    const int k0 = 64 * kb, n0 = 32 * nb;
#pragma unroll 8
    for (int i = 0; i < 32; ++i) { const int kk = 2 * i + (lane >> 5); float v = W[(size_t)(k0 + kk) * spitch + scol + n0 + (lane & 31)]; if (gain) v *= gain[k0 + kk]; scr[kk * 33 + (lane & 31)] = v; }
    LDS_WAIT(); asm volatile("" ::: "memory");
    const int c = lane & 7;
#pragma unroll
    for (int j = 0; j < 4; ++j) { const int n = (lane >> 3) + 8 * j; const LAS float* s = scr + (8 * c) * 33 + n;
        v4u o; o.x = pk2(s[0 * 33], s[1 * 33]); o.y = pk2(s[2 * 33], s[3 * 33]); o.z = pk2(s[4 * 33], s[5 * 33]); o.w = pk2(s[6 * 33], s[7 * 33]);
        *(GAS v4u*)(WT + (size_t)(n0 + n) * dpitch + dk0 + k0 + 8 * c) = o; }
    LDS_WAIT(); asm volatile("" ::: "memory");
}
__device__ __forceinline__ void p_convert(Frame& F) {
    LAS float* scr = (LAS float*)(F.lds + RING_OFF + F.wave * 16384);
    const int gw = F.wg * NWAVES + F.wave, NGW = F.G * NWAVES;
    constexpr int I_IN = 16 * 224, I_GLU = 8 * 16, I_BR = 8 * 32, I_OUT = 16 * 32, I_FF1 = 16 * 128, I_FF2 = 64 * 32;
    constexpr int I_LAYER = I_IN + I_GLU + 3 * I_BR + I_OUT + I_FF1 + I_FF2;
    for (int it = gw; it < DEPTH * I_LAYER; it += NGW) {
        const int l = it / I_LAYER; int r = it % I_LAYER;
        unsigned char* wl = F.ws + WS_WT + (size_t)l * WT_LAYER;
        if (r < I_IN) { const int kb = r / 224, nb = r % 224; const int n0 = nb * 32; const int scol = (n0 >= 2560) ? 8 : 0;
            transpose_item(F.in[1] + (size_t)l * 1024 * 7176, 7176, scol, (bf16*)(wl + WT_IN), 1024, 0, F.in[22] + l * 1024, scr, kb, nb, F.lane); continue; } r -= I_IN;
        if (r < I_GLU) { transpose_item(F.in[11] + (size_t)l * 512 * 512, 512, 0, (bf16*)(wl + WT_GLU), 512, 0, nullptr, scr, r / 16, r % 16, F.lane); continue; } r -= I_GLU;
        if (r < 3 * I_BR) { const int br = r / I_BR, rr = r % I_BR; const float* src = F.in[16 + br] + (size_t)l * 512 * 1024;
            transpose_item(src, 1024, 0, (bf16*)(wl + WT_BR), 1536, 512 * br, nullptr, scr, rr / 32, rr % 32, F.lane); continue; } r -= 3 * I_BR;
        if (r < I_OUT) { transpose_item(F.in[19] + (size_t)l * 1024 * 1024, 1024, 0, (bf16*)(wl + WT_OUT), 1024, 0, nullptr, scr, r / 32, r % 32, F.lane); continue; } r -= I_OUT;
        if (r < I_FF1) { transpose_item(F.in[20] + (size_t)l * 1024 * 4096, 4096, 0, (bf16*)(wl + WT_FF1), 1024, 0, F.in[24] + l * 1024, scr, r / 128, r % 128, F.lane); continue; } r -= I_FF1;
        transpose_item(F.in[21] + (size_t)l * 4096 * 1024, 1024, 0, (bf16*)(wl + WT_FF2), 4096, 0, nullptr, scr, r / 32, r % 32, F.lane);
    }
    for (int i = gw * 64 + F.lane; i < DEPTH * 8 * 1024; i += NGW * 64) { const int l = i >> 13, j = (i >> 10) & 7, k = i & 1023;
        F.WG8[i] = F.in[1][((size_t)l * 1024 + k) * 7176 + 2560 + j] * F.in[22][l * 1024 + k]; }
}

__device__ __forceinline__ void p_rows(Frame& F, const float* xold, const float* tmp, const float* gpost, bool upd, bool next, int g8l) {
    const int gw = F.wg * NWAVES + F.wave, NGW = F.G * NWAVES;
    for (int m = gw; m < M; m += NGW) {
        const GAS f32x4* xr = (const GAS f32x4*)(xold + (size_t)m * D) + F.lane;
        f32x4 v[4];
#pragma unroll
        for (int j = 0; j < 4; ++j) v[j] = xr[64 * j];
        if (upd) {
            const GAS f32x4* tr = (const GAS f32x4*)(tmp + (size_t)m * D) + F.lane; f32x4 t[4]; float s = 0.f;
#pragma unroll
            for (int j = 0; j < 4; ++j) { t[j] = tr[64 * j]; s += (t[j].x * t[j].x + t[j].y * t[j].y) + (t[j].z * t[j].z + t[j].w * t[j].w); }
            const float rs = 1.0f / sqrtf(wave_sum(s) * (1.f / D) + RMS_EPS);
            GAS f32x4* orow = (GAS f32x4*)(F.out + (size_t)m * D) + F.lane;
#pragma unroll
            for (int j = 0; j < 4; ++j) { const f32x4 gp = *((const GAS f32x4*)gpost + F.lane + 64 * j); v[j] = v[j] + t[j] * rs * gp; orow[64 * j] = v[j]; }
        }
        if (next) {
            float s2 = 0.f;
#pragma unroll
            for (int j = 0; j < 4; ++j) s2 += (v[j].x * v[j].x + v[j].y * v[j].y) + (v[j].z * v[j].z + v[j].w * v[j].w);
            const float rstd = 1.0f / sqrtf(wave_sum(s2) * (1.f / D) + RMS_EPS);
            if (F.lane == 0) F.RSTD[m] = rstd;
            GAS v2u* o8 = (GAS v2u*)(F.XB + (size_t)m * D) + F.lane;
#pragma unroll
            for (int j = 0; j < 4; ++j) { v2u w; w.x = pk2(v[j].x, v[j].y); w.y = pk2(v[j].z, v[j].w); o8[64 * j] = w; }
            if (g8l >= 0) {
                float myv = 0.f;
#pragma unroll
                for (int q = 0; q < 8; ++q) { const GAS f32x4* wr = (const GAS f32x4*)(F.WG8 + ((size_t)g8l * 8 + q) * 1024) + F.lane; float d = 0.f;
#pragma unroll
                    for (int j = 0; j < 4; ++j) { const f32x4 w = wr[64 * j]; d += (v[j].x * w.x + v[j].y * w.y) + (v[j].z * w.z + v[j].w * w.w); }
                    d = wave_sum(d) * rstd; if (F.lane == q) myv = d; }
                if (F.lane < 8) F.G8[(size_t)m * 8 + F.lane] = myv;
            }
        }
    }
}

struct SsmCoef { float ar, ai; float bbr[16], bbi[16]; };
__device__ __forceinline__ void ssm_coef(Frame& F, int l, int g, int p, SsmCoef& c) {
    const float lr = F.in[3][(l * 32 + g) * 64 + p], li = F.in[4][(l * 32 + g) * 64 + p];
    const float dt = expf(F.in[5][l * 32 + g]);
    const float dec = expf(dt * lr); const float ang = dt * li;
    c.ar = dec * cosf(ang); c.ai = dec * sinf(ang);
    const float den = lr * lr + li * li, nr = c.ar - 1.0f, ni = c.ai;
    const float fr = (nr * lr + ni * li) / den, fi = (ni * lr - nr * li) / den;
    const GAS f32x4* br = (const GAS f32x4*)(F.in[6] + ((size_t)(l * 32 + g) * 64 + p) * 16);
    const GAS f32x4* bi = (const GAS f32x4*)(F.in[7] + ((size_t)(l * 32 + g) * 64 + p) * 16);
#pragma unroll
    for (int q = 0; q < 4; ++q) { const f32x4 r = br[q], i = bi[q];
#pragma unroll
        for (int e = 0; e < 4; ++e) { c.bbr[4 * q + e] = fr * r[e] - fi * i[e]; c.bbi[4 * q + e] = fr * i[e] + fi * r[e]; } }
}
__device__ __forceinline__ void ssm_bu(const SsmCoef& c, const bf16* urow, float& bur, float& bui) {
    const v4u u0 = *(const GAS v4u*)urow, u1 = *((const GAS v4u*)urow + 1);
    const unsigned w[8] = {u0.x, u0.y, u0.z, u0.w, u1.x, u1.y, u1.z, u1.w};
    float r = 0.f, i = 0.f;
#pragma unroll
    for (int q = 0; q < 8; ++q) { const float a = bflo(w[q]), b = bfhi(w[q]); r += c.bbr[2 * q] * a + c.bbr[2 * q + 1] * b; i += c.bbi[2 * q] * a + c.bbi[2 * q + 1] * b; }
    bur = r; bui = i;
}
__device__ __forceinline__ void p_ssm_states(Frame& F, int l) {
    const int gw = F.wg * NWAVES + F.wave, NGW = F.G * NWAVES;
    for (int u = gw; u < NB * 32 * SSM_NC; u += NGW) {
        const int c = u % SSM_NC, g = (u / SSM_NC) % 32, b = u / (SSM_NC * 32);
        SsmCoef cf; ssm_coef(F, l, g, F.lane, cf);
        float sr = 0.f, si = 0.f;
        const bf16* up = F.PROJ + (size_t)(b * SEQ + c * SSM_L) * NP + C_U + g * 16;
        for (int t = 0; t < SSM_L; ++t) { float bur, bui; ssm_bu(cf, up + (size_t)t * NP, bur, bui);
            const float nr = cf.ar * sr - cf.ai * si + bur, ni = cf.ar * si + cf.ai * sr + bui; sr = nr; si = ni; }
        float* o = F.SLOC + ((size_t)(b * SSM_NC + c) * 32 + g) * 128;
        o[F.lane] = sr; o[64 + F.lane] = si;
    }
}
__device__ __forceinline__ float gelu_tanh(float x) { const float u = 0.7978845608028654f * (x + 0.044715f * x * x * x); return 0.5f * x * (1.0f + tanhf(u)); }
__device__ __forceinline__ void p_ssm_out(Frame& F, int l) {
    const int gw = F.wg * NWAVES + F.wave, NGW = F.G * NWAVES;
    LAS float* CC = (LAS float*)(F.lds + F.wave * 16896); LAS float* ST = CC + 16 * 132;
    const int lane = F.lane;
    for (int u = gw; u < NB * 32 * SSM_NC; u += NGW) {
        const int c = u % SSM_NC, g = (u / SSM_NC) % 32, b = u / (SSM_NC * 32);
        SsmCoef cf; ssm_coef(F, l, g, lane, cf);
        for (int h = 0; h < 16; ++h) { CC[h * 132 + lane] = F.in[8][((size_t)(l * 32 + g) * 16 + h) * 64 + lane]; CC[h * 132 + 64 + lane] = -F.in[9][((size_t)(l * 32 + g) * 16 + h) * 64 + lane]; }
        float pr = cf.ar, pi = cf.ai;
#pragma unroll
        for (int q = 0; q < 6; ++q) { const float nr = pr * pr - pi * pi, ni = 2.f * pr * pi; pr = nr; pi = ni; }
        float sr = 0.f, si = 0.f;
        for (int cc = 0; cc < c; ++cc) { const float* sl = F.SLOC + ((size_t)(b * SSM_NC + cc) * 32 + g) * 128; const float lr = sl[lane], li = sl[64 + lane];
            const float nr = pr * sr - pi * si + lr, ni = pr * si + pi * sr + li; sr = nr; si = ni; }
        bf16* up = F.PROJ + (size_t)(b * SEQ + c * SSM_L) * NP + C_U + g * 16;
        const int tt = lane >> 2, hg = lane & 3;
        float dsk[4];
#pragma unroll
        for (int i = 0; i < 4; ++i) dsk[i] = F.in[10][l * 512 + g * 16 + hg * 4 + i];
        for (int tb = 0; tb < SSM_L / 16; ++tb) {
#pragma unroll 4
            for (int t = 0; t < 16; ++t) { float bur, bui; ssm_bu(cf, up + (size_t)(tb * 16 + t) * NP, bur, bui);
                const float nr = cf.ar * sr - cf.ai * si + bur, ni = cf.ar * si + cf.ai * sr + bui; sr = nr; si = ni;
                ST[t * 132 + lane] = sr; ST[t * 132 + 64 + lane] = si; }
            LDS_WAIT(); asm volatile("" ::: "memory");
            float y[4] = {0.f, 0.f, 0.f, 0.f};
#pragma unroll 4
            for (int q = 0; q < 32; ++q) { const f32x4 s4 = *(const LAS f32x4*)(ST + tt * 132 + 4 * q);
#pragma unroll
                for (int i = 0; i < 4; ++i) { const f32x4 c4 = *(const LAS f32x4*)(CC + (hg * 4 + i) * 132 + 4 * q); y[i] += (c4.x * s4.x + c4.y * s4.y) + (c4.z * s4.z + c4.w * s4.w); } }
            bf16* yp = up + (size_t)(tb * 16 + tt) * NP + hg * 4;
            const v2u uu = *(const GAS v2u*)yp;
            const float u4[4] = {bflo(uu.x), bfhi(uu.x), bflo(uu.y), bfhi(uu.y)};
#pragma unroll
            for (int i = 0; i < 4; ++i) y[i] = gelu_tanh(y[i] + dsk[i] * u4[i]);
            LDS_WAIT(); asm volatile("" ::: "memory");
            v2u w; w.x = pk2(y[0], y[1]); w.y = pk2(y[2], y[3]);
            *(GAS v2u*)yp = w;
        }
        LDS_WAIT(); asm volatile("" ::: "memory");
    }
}

__device__ __forceinline__ float log_sigmoid(float x) { return fminf(x, 0.f) - log1pf(expf(-fabsf(x))); }
__device__ __forceinline__ float siluf_(float x) { return x / (1.0f + __expf(-x)); }
__device__ __forceinline__ void conv8(const bf16* base  , size_t row, int sl, const float* cw, float (&o)[8]) {
#pragma unroll
    for (int i = 0; i < 8; ++i) o[i] = 0.f;
#pragma unroll
    for (int tap = 0; tap < 4; ++tap) {
        const int d = 3 - tap;
        if (sl - d >= 0) {
            const v4u x = *(const GAS v4u*)(base + (row - d) * NP);
            const f32x4 w0 = *(const GAS f32x4*)(cw + tap * 1024), w1 = *(const GAS f32x4*)(cw + tap * 1024 + 4);
            o[0] += w0.x * bflo(x.x); o[1] += w0.y * bfhi(x.x); o[2] += w0.z * bflo(x.y); o[3] += w0.w * bfhi(x.y);
            o[4] += w1.x * bflo(x.z); o[5] += w1.y * bfhi(x.z); o[6] += w1.z * bflo(x.w); o[7] += w1.w * bfhi(x.w);
        }
    }
#pragma unroll
    for (int i = 0; i < 8; ++i) o[i] = siluf_(o[i]);
}
constexpr int MLP = 136;
__device__ __forceinline__ void p_mlstm_dc(Frame& F, int l) {
    LAS bf16* KT = (LAS bf16*)F.lds;
    LAS bf16* VT = KT + 128 * MLP;
    LAS float* GA = (LAS float*)(VT + 160 * MLP);
    const int tid = F.tid, lane = F.lane, r32 = lane & 31, hf = lane >> 5;
    for (int u = F.wg; u < NB * 4 * ML_NC; u += F.G) {
        const int c = u % ML_NC, h = (u / ML_NC) % 4, b = u / (ML_NC * 4);
        const size_t R0 = (size_t)b * SEQ + c * ML_L;
        __syncthreads();
        if (tid < 128) { const float ip = F.G8[(R0 + tid) * 8 + h] + F.in[12][l * 4 + h]; const float fp = F.G8[(R0 + tid) * 8 + 4 + h] + F.in[13][l * 4 + h];
            GA[tid] = log_sigmoid(fp); GA[256 + tid] = ip; }
        for (int i = tid; i < 31 * MLP; i += 512) VT[129 * MLP + i] = 0;
        __syncthreads();
        if (tid < 128) { float s = 0.f; for (int r = 0; r <= tid; ++r) s += GA[r]; GA[128 + tid] = s; }
        __syncthreads();
        float mloc = -INFINITY, gtot = GA[128 + 127];
        for (int r = 0; r < 128; ++r) mloc = fmaxf(mloc, gtot - GA[128 + r] + GA[256 + r]);
        if (tid < 128) GA[384 + tid] = expf(gtot - GA[128 + tid] + GA[256 + tid] - mloc);
        if (tid == 0) { F.STATS[u * 2] = gtot; F.STATS[u * 2 + 1] = mloc; }
        __syncthreads();
#pragma unroll 1
        for (int it = 0; it < 4; ++it) { const int piece = tid + 512 * it, s = piece & 127, cg = piece >> 7;
            float kv[8]; conv8(F.PROJ + C_MK + h * 128 + cg * 8, R0 + s, c * ML_L + s, F.in[2] + (size_t)l * 4096 + 512 + h * 128 + cg * 8, kv);
            const v4u x = *(const GAS v4u*)(F.PROJ + (R0 + s) * NP + C_MV + h * 128 + cg * 8); const float w = GA[384 + s];
            const float vv[8] = {bflo(x.x), bfhi(x.x), bflo(x.y), bfhi(x.y), bflo(x.z), bfhi(x.z), bflo(x.w), bfhi(x.w)};
#pragma unroll
            for (int i = 0; i < 8; ++i) { KT[(cg * 8 + i) * MLP + s] = (bf16)f2bf(kv[i] * 0.08838834764831845f); VT[(cg * 8 + i) * MLP + s] = (bf16)f2bf(vv[i] * w); } }
        if (tid < 128) VT[128 * MLP + tid] = (bf16)f2bf(GA[384 + tid]);
        __syncthreads();
        bf16* dc = F.DC + (size_t)u * DC_UNIT;
        for (int tile = F.wave; tile < 20; tile += 8) { const int rb = tile >> 2, cb = tile & 3;
            f32x16 acc;
#pragma unroll
            for (int i = 0; i < 16; ++i) acc[i] = 0.f;
#pragma unroll
            for (int ks = 0; ks < 8; ++ks) { const bf16x8 a = *(const LAS bf16x8*)(VT + (rb * 32 + r32) * MLP + 16 * ks + 8 * hf); const bf16x8 bb = *(const LAS bf16x8*)(KT + (cb * 32 + r32) * MLP + 16 * ks + 8 * hf);
                acc = MFMA32(a, bb, acc); }
#pragma unroll
            for (int i = 0; i < 16; ++i) { const int row = rb * 32 + crow(i, hf); if (row < DC_ROWS) dc[row * 128 + cb * 32 + r32] = (bf16)f2bf(acc[i]); }
        }
    }
    __syncthreads();
}
__device__ __forceinline__ void p_mlstm_scan(Frame& F) {
    for (int u = F.wg; u < NB * 4 * 8; u += F.G) { const int bh = u >> 3, sl = u & 7;
        float a[16], bb[16]; float m = 0.f;
#pragma unroll
        for (int c = 0; c < 16; ++c) { const float g = F.STATS[(bh * 16 + c) * 2], ml = F.STATS[(bh * 16 + c) * 2 + 1];
            if (sl == 0 && F.tid == 0) F.MPREV[bh * 16 + c] = m;
            const float mn = fmaxf(g + m, ml); a[c] = expf(g + m - mn); bb[c] = expf(ml - mn); m = mn; }
        for (int e = sl * 2064 + F.tid; e < (sl + 1) * 2064; e += 512) { float C = 0.f; bf16* p = F.DC + (size_t)bh * 16 * DC_UNIT + e;
#pragma unroll
            for (int c = 0; c < 16; ++c) { const float d = bf2f(p[(size_t)c * DC_UNIT]); p[(size_t)c * DC_UNIT] = (bf16)f2bf(C); C = a[c] * C + bb[c] * d; } }
    }
}
__device__ __forceinline__ void p_mlstm_out(Frame& F, int l) {
    const int tid = F.tid, lane = F.lane, r32 = lane & 31, hf = lane >> 5, half = F.wave >> 2, jb = F.wave & 3, ht = tid & 255;
    LAS unsigned char* hb = F.lds + half * 71680;
    LAS bf16* KH = (LAS bf16*)hb; LAS bf16* VT = KH + 128 * MLP; LAS float* GA = (LAS float*)(hb + 69632);
    for (int u0 = F.wg * 2; u0 < NB * 4 * ML_NC; u0 += F.G * 2) {
        const int u = u0 + half; const int c = u % ML_NC, h = (u / ML_NC) % 4, b = u / (ML_NC * 4);
        const size_t R0 = (size_t)b * SEQ + c * ML_L;
        __syncthreads();
        if (ht < 128) { const float ip = F.G8[(R0 + ht) * 8 + h] + F.in[12][l * 4 + h]; const float fp = F.G8[(R0 + ht) * 8 + 4 + h] + F.in[13][l * 4 + h];
            GA[384 + ht] = log_sigmoid(fp); GA[128 + ht] = ip; }
        __syncthreads();
        if (ht < 128) { float s = 0.f; for (int r = 0; r <= ht; ++r) s += GA[384 + r]; GA[ht] = s; }
        __syncthreads();
        if (ht < 128) { float pm = -INFINITY; for (int r = 0; r <= ht; ++r) pm = fmaxf(pm, GA[128 + r] - GA[r]); GA[256 + ht] = pm; }
#pragma unroll 1
        for (int it = 0; it < 8; ++it) { const int piece = ht + 256 * it, s = piece >> 4, cg = piece & 15;
            float kv[8]; conv8(F.PROJ + C_MK + h * 128 + cg * 8, R0 + s, c * ML_L + s, F.in[2] + (size_t)l * 4096 + 512 + h * 128 + cg * 8, kv);
            v4u w; w.x = pk2(kv[0] * 0.08838834764831845f, kv[1] * 0.08838834764831845f); w.y = pk2(kv[2] * 0.08838834764831845f, kv[3] * 0.08838834764831845f);
            w.z = pk2(kv[4] * 0.08838834764831845f, kv[5] * 0.08838834764831845f); w.w = pk2(kv[6] * 0.08838834764831845f, kv[7] * 0.08838834764831845f);
            *(LAS v4u*)(KH + s * MLP + cg * 8) = w; }
#pragma unroll 1
        for (int it = 0; it < 8; ++it) { const int piece = ht + 256 * it, s = piece & 127, cg = piece >> 7;
            const v4u x = *(const GAS v4u*)(F.PROJ + (R0 + s) * NP + C_MV + h * 128 + cg * 8);
            const unsigned short e[8] = {(unsigned short)x.x, (unsigned short)(x.x >> 16), (unsigned short)x.y, (unsigned short)(x.y >> 16), (unsigned short)x.z, (unsigned short)(x.z >> 16), (unsigned short)x.w, (unsigned short)(x.w >> 16)};
#pragma unroll
            for (int i = 0; i < 8; ++i) VT[(cg * 8 + i) * MLP + s] = e[i]; }
        bf16x8 qf[8];
        { const int jl = jb * 32 + r32;
#pragma unroll
            for (int ks = 0; ks < 8; ++ks) { float qv[8]; conv8(F.PROJ + C_MQ + h * 128 + 16 * ks + 8 * hf, R0 + jl, c * ML_L + jl, F.in[2] + (size_t)l * 4096 + h * 128 + 16 * ks + 8 * hf, qv);
                v4u w; w.x = pk2(qv[0], qv[1]); w.y = pk2(qv[2], qv[3]); w.z = pk2(qv[4], qv[5]); w.w = pk2(qv[6], qv[7]); qf[ks] = __builtin_bit_cast(bf16x8, w); } }
        __syncthreads();
        const int jl = jb * 32 + r32;
        const float bcj = GA[jl], mprev = F.MPREV[u];
        const float linter = bcj + mprev, mintra = bcj + GA[256 + jl];
        const float mq = fmaxf(linter, mintra), inter = expf(linter - mq);
        f32x16 o[5];
        const bf16* cp = F.DC + (size_t)u * DC_UNIT;
#pragma unroll
        for (int vb = 0; vb < 5; ++vb) {
#pragma unroll
            for (int i = 0; i < 16; ++i) o[vb][i] = 0.f;
            const int row = vb * 32 + r32; const bool ok = row < DC_ROWS;
#pragma unroll
            for (int ks = 0; ks < 8; ++ks) { v4u a = {0u, 0u, 0u, 0u}; if (ok) a = *(const GAS v4u*)(cp + row * 128 + 16 * ks + 8 * hf);
                o[vb] = MFMA32(__builtin_bit_cast(bf16x8, a), qf[ks], o[vb]); }
#pragma unroll
            for (int i = 0; i < 16; ++i) o[vb][i] *= inter;
        }
        float dsum = 0.f;
#pragma unroll 1
        for (int sb = 0; sb <= jb; ++sb) {
            f32x16 st;
#pragma unroll
            for (int i = 0; i < 16; ++i) st[i] = 0.f;
#pragma unroll
            for (int ks = 0; ks < 8; ++ks) { const bf16x8 a = *(const LAS bf16x8*)(KH + (sb * 32 + r32) * MLP + 16 * ks + 8 * hf); st = MFMA32(a, qf[ks], st); }
            unsigned pw[8];
#pragma unroll
            for (int i = 0; i < 16; i += 2) { float p2[2];
#pragma unroll
                for (int e = 0; e < 2; ++e) { const int s = sb * 32 + crow(i + e, hf); const float ld = bcj - GA[s] + GA[128 + s] - mq; p2[e] = (s <= jl) ? st[i + e] * expf(ld) : 0.f; dsum += p2[e]; }
                pw[i >> 1] = pk2(p2[0], p2[1]); }
#pragma unroll
            for (int step = 0; step < 2; ++step) { v4u pv = {pw[4 * step], pw[4 * step + 1], pw[4 * step + 2], pw[4 * step + 3]}; const bf16x8 pb = __builtin_bit_cast(bf16x8, pv);
#pragma unroll
                for (int vb = 0; vb < 4; ++vb) { const LAS bf16* vr = VT + (vb * 32 + r32) * MLP + sb * 32 + 16 * step + 4 * hf;
                    const v2u lo = *(const LAS v2u*)vr, hi = *(const LAS v2u*)(vr + 8); v4u a = {lo.x, lo.y, hi.x, hi.y};
                    o[vb] = MFMA32(__builtin_bit_cast(bf16x8, a), pb, o[vb]); } }
        }
        dsum += __shfl_xor(dsum, 32);
        const float nq = __shfl(o[4][0], r32);
        const float den = dsum + nq;
        const float dmax = fmaxf(fabsf(den), expf(-mq)); const float rd = 1.0f / dmax;
        float ss = 0.f;
#pragma unroll
        for (int vb = 0; vb < 4; ++vb)
#pragma unroll
            for (int i = 0; i < 16; ++i) { o[vb][i] *= rd; ss += o[vb][i] * o[vb][i]; }
        ss += __shfl_xor(ss, 32);
        const float sc = 1.0f / sqrtf(ss * (1.f / 128.f) + RMS_EPS);
        __syncthreads();
        LAS float* OST = (LAS float*)(hb + jb * 16896);
#pragma unroll
        for (int vb = 0; vb < 4; ++vb)
#pragma unroll
            for (int i = 0; i < 16; ++i) { const int v = vb * 32 + crow(i, hf); OST[r32 * 132 + v] = o[vb][i] * sc * F.in[14][l * 512 + h * 128 + v]; }
        LDS_WAIT(); asm volatile("" ::: "memory");
#pragma unroll 1
        for (int it = 0; it < 8; ++it) { const int piece = lane + 64 * it, rr = piece >> 4, cg = piece & 15;
            bf16* gp = F.PROJ + (R0 + jb * 32 + rr) * NP + C_MO + h * 128 + cg * 8;
            const v4u x = *(const GAS v4u*)gp; const f32x4 h0 = *(const LAS f32x4*)(OST + rr * 132 + cg * 8), h1 = *(const LAS f32x4*)(OST + rr * 132 + cg * 8 + 4);
            v4u w; w.x = pk2(sigmoidf_(bflo(x.x)) * h0.x, sigmoidf_(bfhi(x.x)) * h0.y); w.y = pk2(sigmoidf_(bflo(x.y)) * h0.z, sigmoidf_(bfhi(x.y)) * h0.w);
            w.z = pk2(sigmoidf_(bflo(x.z)) * h1.x, sigmoidf_(bfhi(x.z)) * h1.y); w.w = pk2(sigmoidf_(bflo(x.w)) * h1.z, sigmoidf_(bfhi(x.w)) * h1.w);
            *(GAS v4u*)gp = w; }
    }
    __syncthreads();
}

__device__ __forceinline__ void p_kmean(Frame& F) {
    LAS float* PS = (LAS float*)F.lds;
    for (int u = F.wg; u < NB * 8 * 8; u += F.G) { const int n = u & 7, h = (u >> 3) & 7, b = u >> 6;
        const int d = F.tid & 63, part = F.tid >> 6; float s = 0.f;
        const bf16* kp = F.PROJ + ((size_t)b * SEQ + n * 256 + part * 32) * NP + C_AK + h * 64 + d;
        for (int r = 0; r < 32; ++r) s += bf2f(kp[(size_t)r * NP]);
        __syncthreads(); PS[part * 64 + d] = s; __syncthreads();
        if (F.tid < 64) { float t = 0.f; for (int p = 0; p < 8; ++p) t += PS[p * 64 + F.tid]; F.KM[(size_t)u * 64 + F.tid] = t * (1.f / 256.f); }
    }
    __syncthreads();
}
constexpr int ATP = 72;
__device__ __forceinline__ void p_moba(Frame& F) {
    LAS bf16* KS = (LAS bf16*)F.lds;
    LAS bf16* VT = KS + 64 * ATP;
    LAS float* BD = (LAS float*)(VT + 64 * ATP);
    LAS float* KMS = BD + 132;
    LAS bf16* OST = (LAS bf16*)(KMS + 512) + F.wave * 32 * ATP;
    const int tid = F.tid, lane = F.lane, r32 = lane & 31, hf = lane >> 5, w = F.wave;
    for (int pu = F.wg; pu < 256; pu += F.G) { const int pr = pu & 3, bh = pu >> 2, h = bh & 7, b = bh >> 3;
#pragma unroll 1
      for (int side = 0; side < 2; ++side) { const int cur = side ? 7 - pr : pr;
        __syncthreads();
        if (tid < 129) { int bk; if (tid < 16) bk = tid; else { bk = 16 + (int)(logf((float)tid * (1.0f / 16.0f)) / 2.0794415416798357f * 16.0f); bk = bk < 31 ? bk : 31; } BD[tid] = F.in[15][h * 32 + bk]; }
        KMS[tid] = F.KM[(size_t)bh * 512 + tid];
        __syncthreads();
        const int ql = w * 32 + r32;
        const size_t qrow = (size_t)b * SEQ + cur * 256 + ql;
        bf16x8 qf[4];
#pragma unroll
        for (int ks = 0; ks < 4; ++ks) qf[ks] = *(const GAS bf16x8*)(F.PROJ + qrow * NP + C_AQ + h * 64 + 16 * ks + 8 * hf);
        unsigned allow = 0u;
        { float gt[7];
#pragma unroll
          for (int n = 0; n < 7; ++n) { float s = 0.f;
#pragma unroll
              for (int ks = 0; ks < 4; ++ks)
#pragma unroll
                  for (int j = 0; j < 8; ++j) s += bf2f((unsigned short)qf[ks][j]) * KMS[n * 64 + 16 * ks + 8 * hf + j];
              s += __shfl_xor(s, 32); gt[n] = s; }
#pragma unroll
          for (int n = 0; n < 7; ++n) { int rank = 0;
#pragma unroll
              for (int n2 = 0; n2 < 7; ++n2) if (n2 != n && n2 < cur) rank += (gt[n2] > gt[n] || (gt[n2] == gt[n] && n2 < n)) ? 1 : 0;
              if (n < cur && rank < 3) allow |= 1u << n; } }
        float mrun = -1e30f, lrun = 0.f; f32x16 o[2];
#pragma unroll
        for (int i = 0; i < 16; ++i) { o[0][i] = 0.f; o[1][i] = 0.f; }
#pragma unroll 1
        for (int t = 0; t < (cur + 1) * 4; ++t) { const int n = t >> 2, kv0 = t * 64;
            __syncthreads();
            { const int kv = tid >> 3, cg = tid & 7; const size_t kr = (size_t)b * SEQ + kv0 + kv;
              const v4u kx = *(const GAS v4u*)(F.PROJ + kr * NP + C_AK + h * 64 + cg * 8); *(LAS v4u*)(KS + kv * ATP + cg * 8) = kx;
              const v4u x = *(const GAS v4u*)(F.PROJ + kr * NP + C_AV + h * 64 + cg * 8);
              const unsigned short e[8] = {(unsigned short)x.x, (unsigned short)(x.x >> 16), (unsigned short)x.y, (unsigned short)(x.y >> 16), (unsigned short)x.z, (unsigned short)(x.z >> 16), (unsigned short)x.w, (unsigned short)(x.w >> 16)};
#pragma unroll
              for (int i = 0; i < 8; ++i) VT[(cg * 8 + i) * ATP + kv] = e[i]; }
            __syncthreads();
            const int qabs = cur * 256 + ql;
            if (n == cur && kv0 > cur * 256 + w * 32 + 31) continue;
            f32x16 st[2];
#pragma unroll
            for (int rb = 0; rb < 2; ++rb) {
#pragma unroll
                for (int i = 0; i < 16; ++i) st[rb][i] = 0.f;
#pragma unroll
                for (int ks = 0; ks < 4; ++ks) { const bf16x8 a = *(const LAS bf16x8*)(KS + (rb * 32 + r32) * ATP + 16 * ks + 8 * hf); st[rb] = MFMA32(a, qf[ks], st[rb]); } }
            const bool blk_ok = (n == cur) || ((allow >> n) & 1u);
            float mx = -1e30f;
#pragma unroll
            for (int rb = 0; rb < 2; ++rb)
#pragma unroll
                for (int i = 0; i < 16; ++i) { const int kv = kv0 + rb * 32 + crow(i, hf); const int dist = qabs - kv; const int dcl = dist < 0 ? 0 : (dist > 128 ? 128 : dist);
                    float x = st[rb][i] * 0.125f + BD[dcl]; x = (blk_ok && dist >= 0) ? x : -1e30f; st[rb][i] = x; mx = fmaxf(mx, x); }
            mx = fmaxf(mx, __shfl_xor(mx, 32));
            const float mnew = fmaxf(mrun, mx), alpha = __expf(mrun - mnew); mrun = mnew;
            float ps = 0.f; unsigned pw[2][8];
#pragma unroll
            for (int rb = 0; rb < 2; ++rb)
#pragma unroll
                for (int i = 0; i < 16; i += 2) { const float p0 = __expf(st[rb][i] - mnew), p1 = __expf(st[rb][i + 1] - mnew); ps += p0 + p1; pw[rb][i >> 1] = pk2(p0, p1); }
            lrun = lrun * alpha + ps;
#pragma unroll
            for (int i = 0; i < 16; ++i) { o[0][i] *= alpha; o[1][i] *= alpha; }
#pragma unroll
            for (int rb = 0; rb < 2; ++rb)
#pragma unroll
                for (int step = 0; step < 2; ++step) { v4u pv = {pw[rb][4 * step], pw[rb][4 * step + 1], pw[rb][4 * step + 2], pw[rb][4 * step + 3]}; const bf16x8 pb = __builtin_bit_cast(bf16x8, pv);
#pragma unroll
                    for (int db = 0; db < 2; ++db) { const LAS bf16* vr = VT + (db * 32 + r32) * ATP + rb * 32 + 16 * step + 4 * hf;
                        const v2u lo = *(const LAS v2u*)vr, hi = *(const LAS v2u*)(vr + 8); v4u a = {lo.x, lo.y, hi.x, hi.y};
                        o[db] = MFMA32(__builtin_bit_cast(bf16x8, a), pb, o[db]); } }
        }
        lrun += __shfl_xor(lrun, 32);
        const float rl = 1.0f / lrun;
#pragma unroll
        for (int db = 0; db < 2; ++db)
#pragma unroll
            for (int i = 0; i < 16; ++i) OST[r32 * ATP + db * 32 + crow(i, hf)] = (bf16)f2bf(o[db][i] * rl);
        LDS_WAIT(); asm volatile("" ::: "memory");
#pragma unroll
        for (int it = 0; it < 4; ++it) { const int piece = lane + 64 * it, rr = piece >> 3, cg = piece & 7;
            const v4u v = *(const LAS v4u*)(OST + rr * ATP + cg * 8);
            *(GAS v4u*)(F.PROJ + ((size_t)b * SEQ + cur * 256 + w * 32 + rr) * NP + C_YMOBA + h * 64 + cg * 8) = v; }
        LDS_WAIT(); asm volatile("" ::: "memory");
      }
    }
    __syncthreads();
}

constexpr int N_STEPS = 2 + 10 * DEPTH;
__global__ void __launch_bounds__(NWAVES * 64, 2) fwd(Args args) {
    extern __shared__ __attribute__((aligned(16))) unsigned char lds[];
    Frame F;
    F.lds = (LAS unsigned char*)lds;
    F.tid = threadIdx.x; F.lane = F.tid & 63; F.wave = __builtin_amdgcn_readfirstlane(F.tid >> 6);
    F.G = gridDim.x; F.wg = blockIdx.x;
    F.in = args.in; F.out = args.out; F.ws = args.ws;
    unsigned char* ws = args.ws;
    F.XB = (bf16*)(ws + WS_XB); F.PROJ = (bf16*)(ws + WS_PROJ); F.DC = (bf16*)(ws + WS_DC); F.SLOC = (float*)(ws + WS_SLOC);
    F.RSTD = (float*)(ws + WS_SMALL + SM_RSTD); F.G8 = (float*)(ws + WS_SMALL + SM_G8); F.KM = (float*)(ws + WS_SMALL + SM_KM);
    F.STATS = (float*)(ws + WS_SMALL + SM_STATS); F.MPREV = (float*)(ws + WS_SMALL + SM_MPREV); F.WG8 = (float*)(ws + WS_SMALL + SM_WG8);
    volatile LAS unsigned* MISC = (volatile LAS unsigned*)(F.lds + MISC_OFF);
    for (int u = F.tid; u < (LDS_BYTES - LDSCTL_OFF) / 4; u += NWAVES * 64) ((LAS unsigned*)(F.lds + LDSCTL_OFF))[u] = 0u;
    __syncthreads();
    const int lo = args.s_lo, hi = args.s_hi;
    XcdBarrier bar; bar.bar = (unsigned*)(ws + WS_CTL) + CW_BAR; bar.x = 0; bar.st = nullptr;
    if (hi - lo > 1) bar = xcd_barrier_post((unsigned*)(ws + WS_CTL) + CW_BAR, MISC + 8);
#define IN(k) (lo <= (k) && (k) < hi)
#define SEAM(k) do { if ((k) + 1 < hi) xcd_barrier(bar); } while (0)

    if (IN(0)) { p_convert(F); SEAM(0); }
    if (IN(1)) { p_rows(F, args.in[0], nullptr, nullptr, false, true, 0); SEAM(1); }

    for (int l = 0; l < DEPTH; ++l) {
        const int s0 = 2 + 10 * l;
        unsigned char* ws = args.ws; asm volatile("" : "+s"(ws));
        float* outp = args.out; asm volatile("" : "+s"(outp));
        { int t_ = threadIdx.x; asm volatile("" : "+v"(t_)); F.tid = t_; F.lane = t_ & 63; F.wave = __builtin_amdgcn_readfirstlane(t_ >> 6);
          int w_ = blockIdx.x; asm volatile("" : "+s"(w_)); F.wg = w_; }
        F.out = outp; F.ws = ws;
        F.XB = (bf16*)(ws + WS_XB); F.PROJ = (bf16*)(ws + WS_PROJ); F.DC = (bf16*)(ws + WS_DC); F.SLOC = (float*)(ws + WS_SLOC);
        F.RSTD = (float*)(ws + WS_SMALL + SM_RSTD); F.G8 = (float*)(ws + WS_SMALL + SM_G8); F.KM = (float*)(ws + WS_SMALL + SM_KM);
        F.STATS = (float*)(ws + WS_SMALL + SM_STATS); F.MPREV = (float*)(ws + WS_SMALL + SM_MPREV); F.WG8 = (float*)(ws + WS_SMALL + SM_WG8);
        unsigned char* wl = ws + WS_WT + (size_t)l * WT_LAYER;
        const float* xold = (l == 0) ? args.in[0] : outp;
        if (IN(s0 + 0)) {
            pg8::Gemm g{F.XB, (const bf16*)(wl + WT_IN), M, NP, D, D, D}; pg8::StaticOrder S; S.init(M, NP, F.G, F.wg);
            pg8::EpiProj E{F.PROJ, NP, F.RSTD, C_G / 256};
            pg8::gemm_phase<pg8::EpiProj, pg8::StaticOrder, true, true>(F.lds + RING_OFF, g, S, E);
            SEAM(s0 + 0);
        }
        if (IN(s0 + 1)) { p_kmean(F); p_ssm_states(F, l); p_mlstm_dc(F, l); SEAM(s0 + 1); }
        if (IN(s0 + 2)) { p_mlstm_scan(F); p_ssm_out(F, l); __syncthreads(); p_moba(F); SEAM(s0 + 2); }
        if (IN(s0 + 3)) {
            p_mlstm_out(F, l);
            pg8::Gemm g{F.PROJ + C_U, (const bf16*)(wl + WT_GLU), M, 512, 512, NP, 512}; pg8::StaticOrder S; S.init(M, 512, F.G, F.wg);
            pg8::EpiGlu E{F.PROJ + C_U, F.PROJ + C_YSSM, NP};
            pg8::gemm_phase<pg8::EpiGlu, pg8::StaticOrder, false, true>(F.lds + RING_OFF, g, S, E);
            SEAM(s0 + 3);
        }
        if (IN(s0 + 4)) {
            pg8::StaticOrder S; S.init(M, D, F.G, F.wg);
            { pg8::Gemm g{F.PROJ + C_YSSM, (const bf16*)(wl + WT_BR), M, D, 512, NP, 1536}; pg8::EpiBranch<1> E{F.PROJ + C_G, NP, F.XB, D};
              pg8::gemm_phase<pg8::EpiBranch<1>, pg8::StaticOrder, false, true>(F.lds + RING_OFF, g, S, E); }
            { pg8::Gemm g{F.PROJ + C_YML, (const bf16*)(wl + WT_BR) + 512, M, D, 512, NP, 1536}; pg8::EpiBranch<0> E{F.PROJ + C_G + 1024, NP, F.XB, D};
              pg8::gemm_phase<pg8::EpiBranch<0>, pg8::StaticOrder, false, true>(F.lds + RING_OFF, g, S, E); }
            { pg8::Gemm g{F.PROJ + C_YMOBA, (const bf16*)(wl + WT_BR) + 1024, M, D, 512, NP, 1536}; pg8::EpiBranch<0> E{F.PROJ + C_G + 2048, NP, F.XB, D};
              pg8::gemm_phase<pg8::EpiBranch<0>, pg8::StaticOrder, false, true>(F.lds + RING_OFF, g, S, E); }
            SEAM(s0 + 4);
        }
        if (IN(s0 + 5)) {
            pg8::Gemm g{F.XB, (const bf16*)(wl + WT_OUT), M, D, D, D, D}; pg8::StaticOrder S; S.init(M, D, F.G, F.wg);
            pg8::EpiF32 E{(float*)(ws + WS_PROJ + PROJ_TMP1), D};
            pg8::gemm_phase<pg8::EpiF32, pg8::StaticOrder, false, true>(F.lds + RING_OFF, g, S, E);
            SEAM(s0 + 5);
        }
        if (IN(s0 + 6)) { p_rows(F, xold, (const float*)(ws + WS_PROJ + PROJ_TMP1), args.in[23] + l * 1024, true, true, -1); SEAM(s0 + 6); }
        if (IN(s0 + 7)) {
            pg8::Gemm g{F.XB, (const bf16*)(wl + WT_FF1), M, FF, D, D, D}; pg8::StaticOrder S; S.init(M, FF, F.G, F.wg);
            pg8::EpiFF1 E{(bf16*)(ws + WS_PROJ + PROJ_HFF), FF, F.RSTD};
            pg8::gemm_phase<pg8::EpiFF1, pg8::StaticOrder, true, true>(F.lds + RING_OFF, g, S, E);
            SEAM(s0 + 7);
        }
        if (IN(s0 + 8)) {
            pg8::Gemm g{(const bf16*)(ws + WS_PROJ + PROJ_HFF), (const bf16*)(wl + WT_FF2), M, D, FF, FF, FF}; pg8::StaticOrder S; S.init(M, D, F.G, F.wg);
            pg8::EpiF32 E{(float*)(ws + WS_PROJ + PROJ_TMP2), D};
            pg8::gemm_phase<pg8::EpiF32, pg8::StaticOrder, false, true>(F.lds + RING_OFF, g, S, E);
            SEAM(s0 + 8);
        }
        if (IN(s0 + 9)) { p_rows(F, outp, (const float*)(ws + WS_PROJ + PROJ_TMP2), args.in[25] + l * 1024, true, l + 1 < DEPTH, l + 1 < DEPTH ? l + 1 : -1); SEAM(s0 + 9); }
    }
#undef IN
#undef SEAM
}

extern "C" void kernel_launch(void* const* d_in, const int* in_sizes, int n_in, void* d_out, int out_size, void* d_ws, size_t ws_size, hipStream_t stream) {
    static int grid = 0;
    if (grid == 0) {
        if (n_in != 26 || out_size != M * D || ws_size < WS_END) { fprintf(stderr, "kernel_launch: unexpected shapes: n_in %d out %d ws %zu (need %zu)\n", n_in, out_size, ws_size, (size_t)WS_END); grid = -1; return; }
        int dev = 0, cus = 0, per_cu = 0;
        if (hipGetDevice(&dev) != hipSuccess || hipDeviceGetAttribute(&cus, hipDeviceAttributeMultiprocessorCount, dev) != hipSuccess) { grid = -1; return; }
        if (hipFuncSetAttribute((const void*)fwd, hipFuncAttributeMaxDynamicSharedMemorySize, LDS_BYTES) != hipSuccess) { fprintf(stderr, "kernel_launch: hipFuncSetAttribute failed\n"); grid = -1; return; }
        if (hipOccupancyMaxActiveBlocksPerMultiprocessor(&per_cu, (const void*)fwd, NWAVES * 64, LDS_BYTES) != hipSuccess || per_cu < 1) fprintf(stderr, "kernel_launch: occupancy query says %d\n", per_cu);
        (void)hipGetLastError();
        grid = cus;
    }
    if (grid < 0) return;
    if (hipMemsetAsync((char*)d_ws + WS_CTL, 0, CTL_ZERO_BYTES, stream) != hipSuccess) return;
    Args a{};
    for (int i = 0; i < 26; ++i) a.in[i] = (const float*)d_in[i];
    a.out = (float*)d_out; a.ws = (unsigned char*)d_ws;
#if MK_ONE_LAUNCH
    a.s_lo = 0; a.s_hi = N_STEPS;
    hipLaunchKernelGGL(fwd, dim3(grid), dim3(NWAVES * 64), LDS_BYTES, stream, a);
#else
    for (int s = 0; s < N_STEPS; ++s) { a.s_lo = s; a.s_hi = s + 1; hipLaunchKernelGGL(fwd, dim3(grid), dim3(NWAVES * 64), LDS_BYTES, stream, a); }
#endif
}
```

```cpp
#include <hip/hip_runtime.h>
#include <cstdio>
#include <cstdint>

#ifndef MK_ONE_LAUNCH
#define MK_ONE_LAUNCH 1
#endif
#ifndef REP_GEMM
#define REP_GEMM 1
#endif
#ifndef REP_MIX
#define REP_MIX 1
#endif
#ifndef REP_ROWS
#define REP_ROWS 1
#endif
#ifndef REP_SSM
#define REP_SSM REP_MIX
#endif
#ifndef REP_ML
#define REP_ML REP_MIX
#endif
#ifndef REP_MOBA
#define REP_MOBA REP_MIX
#endif

namespace pg8 {
#define PG8_LAS __attribute__((address_space(3)))
typedef unsigned short bf16_t;
typedef short bf16x8 __attribute__((ext_vector_type(8)));
typedef float f32x4 __attribute__((ext_vector_type(4)));
typedef unsigned u32x4 __attribute__((ext_vector_type(4)));
constexpr int BM = 256, BK = 64, HALF = 128, HTB = HALF * BK * 2, STAGE_BYTES = 8 * HTB, NXCD = 8, WGM = 8;

__host__ __device__ __forceinline__ int lds_byte(int r, int c) { const int st = (r >> 4) * 2 + (c >> 5), rr = r & 15, cc = c & 31, ob = rr * 64 + cc * 2; return st * 1024 + (ob ^ (((ob >> 9) & 1) << 5)); }
__host__ __device__ __forceinline__ void stage_rc(int b, int& R, int& C) { const int st = b / 1024, sb = b % 1024, swz = sb ^ (((sb >> 9) & 1) << 5); R = (st >> 1) * 16 + swz / 64; C = (st & 1) * 32 + (swz % 64) / 2; }
__host__ __device__ __forceinline__ int perm32(int rho) { const int n = rho >> 4, i = rho & 15; return 8 * (i >> 2) + 4 * n + (i & 3); }

struct Unit { int pm, pn; };
struct Gemm { const bf16_t* A; const bf16_t* Bt; int M, N, K, lda, ldb; };

struct StaticOrder {
    int nM, nN, nwg, G, c;
    __host__ __device__ void init(int M, int N, int G_, int c_) { nM = M / BM; nN = N / BM; nwg = nM * nN; G = G_; c = c_; }
    __host__ __device__ bool next(int i, Unit& u) const {
        const long L = (long)i * G + c; if (L >= nwg) return false;
        int wgid = (int)L; { const int q = nwg / NXCD, r = nwg % NXCD, xcd = wgid % NXCD, off = wgid / NXCD; wgid = (xcd < r ? xcd * (q + 1) : r * (q + 1) + (xcd - r) * q) + off; }
        const int nig = WGM * nN, gid = wgid / nig, fm = gid * WGM, gsz = (nM - fm) < WGM ? (nM - fm) : WGM;
        u.pm = fm + ((wgid % nig) % gsz); u.pn = (wgid % nig) / gsz; return true;
    }
    __device__ __forceinline__ void a_ready(const Unit&) const {}
    __device__ __forceinline__ void done(const Unit&) const {}
};

typedef float f32x2_t __attribute__((ext_vector_type(2))); typedef __bf16 bf16x2_t __attribute__((ext_vector_type(2)));
__device__ __forceinline__ unsigned cvt_pk_bf16(float lo, float hi) { f32x2_t v = {lo, hi}; bf16x2_t b = __builtin_convertvector(v, bf16x2_t); return __builtin_bit_cast(unsigned, b); }
__device__ __forceinline__ float bflo(unsigned w) { return __uint_as_float(w << 16); }
__device__ __forceinline__ float bfhi(unsigned w) { return __uint_as_float(w & 0xffff0000u); }
__device__ __forceinline__ float sigmoidf_(float x) { return 1.0f / (1.0f + __expf(-x)); }

struct EpiProj {
    static constexpr bool PERM = true, AFTER_DRAIN = false;
    bf16_t* O; int ldc; const float* rstd; int gate_pn;
    __device__ __forceinline__ void operator()(const f32x4 (&acc)[2][2][4][2], const Unit& u, int wr, int wc, int fr, int fq) const {
        const int row0 = u.pm * BM + wr * 64 + fr; const int col0 = u.pn * BM + wc * 32 + 8 * fq; const bool sg = u.pn >= gate_pn;
#pragma unroll
        for (int ai = 0; ai < 2; ++ai)
#pragma unroll
            for (int m = 0; m < 4; ++m) { const int row = row0 + ai * HALF + m * 16; const float rs = rstd[row]; bf16_t* rowp = O + (size_t)row * ldc + col0;
#pragma unroll
                for (int bj = 0; bj < 2; ++bj) { f32x4 v0 = acc[ai][bj][m][0] * rs, v1 = acc[ai][bj][m][1] * rs;
                    if (sg) {
#pragma unroll
                        for (int j = 0; j < 4; ++j) { v0[j] = sigmoidf_(v0[j]); v1[j] = sigmoidf_(v1[j]); } }
                    u32x4 w; w.x = cvt_pk_bf16(v0[0], v0[1]); w.y = cvt_pk_bf16(v0[2], v0[3]); w.z = cvt_pk_bf16(v1[0], v1[1]); w.w = cvt_pk_bf16(v1[2], v1[3]);
                    *(u32x4*)(rowp + bj * HALF) = w; } }
    }
};
struct EpiGlu {
    static constexpr bool PERM = true, AFTER_DRAIN = false;
    const bf16_t* Yg; bf16_t* O; int ld;
    __device__ __forceinline__ void operator()(const f32x4 (&acc)[2][2][4][2], const Unit& u, int wr, int wc, int fr, int fq) const {
        const int row0 = u.pm * BM + wr * 64 + fr; const int col0 = u.pn * BM + wc * 32 + 8 * fq;
#pragma unroll
        for (int ai = 0; ai < 2; ++ai)
#pragma unroll
            for (int m = 0; m < 4; ++m) { const size_t ro = (size_t)(row0 + ai * HALF + m * 16) * ld + col0;
#pragma unroll
                for (int bj = 0; bj < 2; ++bj) { const f32x4 v0 = acc[ai][bj][m][0], v1 = acc[ai][bj][m][1];
                    const u32x4 y = *(const u32x4*)(Yg + ro + bj * HALF);
                    u32x4 w;
                    w.x = cvt_pk_bf16(bflo(y.x) * sigmoidf_(v0[0]), bfhi(y.x) * sigmoidf_(v0[1]));
                    w.y = cvt_pk_bf16(bflo(y.y) * sigmoidf_(v0[2]), bfhi(y.y) * sigmoidf_(v0[3]));
                    w.z = cvt_pk_bf16(bflo(y.z) * sigmoidf_(v1[0]), bfhi(y.z) * sigmoidf_(v1[1]));
                    w.w = cvt_pk_bf16(bflo(y.w) * sigmoidf_(v1[2]), bfhi(y.w) * sigmoidf_(v1[3]));
                    *(u32x4*)(O + ro + bj * HALF) = w; } }
    }
};
template <int FIRST> struct EpiBranch {
    static constexpr bool PERM = true, AFTER_DRAIN = false;
    const bf16_t* Gt; int ldg; bf16_t* Mg; int ldm;
    __device__ __forceinline__ void operator()(const f32x4 (&acc)[2][2][4][2], const Unit& u, int wr, int wc, int fr, int fq) const {
        const int row0 = u.pm * BM + wr * 64 + fr; const int col0 = u.pn * BM + wc * 32 + 8 * fq;
#pragma unroll
        for (int ai = 0; ai < 2; ++ai)
#pragma unroll
            for (int m = 0; m < 4; ++m) { const int row = row0 + ai * HALF + m * 16;
#pragma unroll
                for (int bj = 0; bj < 2; ++bj) { const f32x4 v0 = acc[ai][bj][m][0], v1 = acc[ai][bj][m][1];
                    const u32x4 g = *(const u32x4*)(Gt + (size_t)row * ldg + col0 + bj * HALF);
                    float o[8] = { bflo(g.x) * v0[0], bfhi(g.x) * v0[1], bflo(g.y) * v0[2], bfhi(g.y) * v0[3], bflo(g.z) * v1[0], bfhi(g.z) * v1[1], bflo(g.w) * v1[2], bfhi(g.w) * v1[3] };
                    bf16_t* mp = Mg + (size_t)row * ldm + col0 + bj * HALF;
                    if (!FIRST) { const u32x4 p = *(const u32x4*)mp; o[0] += bflo(p.x); o[1] += bfhi(p.x); o[2] += bflo(p.y); o[3] += bfhi(p.y); o[4] += bflo(p.z); o[5] += bfhi(p.z); o[6] += bflo(p.w); o[7] += bfhi(p.w); }
                    u32x4 w; w.x = cvt_pk_bf16(o[0], o[1]); w.y = cvt_pk_bf16(o[2], o[3]); w.z = cvt_pk_bf16(o[4], o[5]); w.w = cvt_pk_bf16(o[6], o[7]);
                    *(u32x4*)mp = w; } }
    }
};
struct EpiF32 {
    static constexpr bool PERM = false, AFTER_DRAIN = false;
    float* C; int ldc;
    __device__ __forceinline__ void operator()(const f32x4 (&acc)[2][2][4][2], const Unit& u, int wr, int wc, int fr, int fq) const {
        const int row0 = u.pm * BM + wr * 64 + fr, col0 = u.pn * BM + wc * 32 + 4 * fq;
#pragma unroll
        for (int ai = 0; ai < 2; ++ai)
#pragma unroll
            for (int m = 0; m < 4; ++m) { float* rowp = C + (size_t)(row0 + ai * HALF + m * 16) * ldc + col0;
#pragma unroll
                for (int bj = 0; bj < 2; ++bj)
#pragma unroll
                    for (int n = 0; n < 2; ++n) *(f32x4*)(rowp + bj * HALF + n * 16) = acc[ai][bj][m][n]; }
    }
};
struct EpiFF1 {
    static constexpr bool PERM = true, AFTER_DRAIN = false;
    bf16_t* O; int ldc; const float* rstd;
    __device__ __forceinline__ void operator()(const f32x4 (&acc)[2][2][4][2], const Unit& u, int wr, int wc, int fr, int fq) const {
        const int row0 = u.pm * BM + wr * 64 + fr; const int col0 = u.pn * BM + wc * 32 + 8 * fq;
#pragma unroll
        for (int ai = 0; ai < 2; ++ai)
#pragma unroll
            for (int m = 0; m < 4; ++m) { const int row = row0 + ai * HALF + m * 16; const float rs = rstd[row]; bf16_t* rowp = O + (size_t)row * ldc + col0;
#pragma unroll
                for (int bj = 0; bj < 2; ++bj) { f32x4 v0 = acc[ai][bj][m][0] * rs, v1 = acc[ai][bj][m][1] * rs;
#pragma unroll
                    for (int j = 0; j < 4; ++j) { const float a = fmaxf(v0[j], 0.f), b = fmaxf(v1[j], 0.f); v0[j] = a * a; v1[j] = b * b; }
                    u32x4 w; w.x = cvt_pk_bf16(v0[0], v0[1]); w.y = cvt_pk_bf16(v0[2], v0[3]); w.z = cvt_pk_bf16(v1[0], v1[1]); w.w = cvt_pk_bf16(v1[2], v1[3]);
                    *(u32x4*)(rowp + bj * HALF) = w; } }
    }
};

template <class Epi, class Sched, bool ALIGN_EPI = false, bool SP2 = false>
__device__ __forceinline__ void gemm_phase(PG8_LAS unsigned char* lds, const Gemm g, const Sched& S, const Epi& E) {
    int tid_ = threadIdx.x; asm volatile("" : "+v"(tid_));
    const int tid = tid_, wid = __builtin_amdgcn_readfirstlane(tid >> 6), lane = tid & 63, wr = wid >> 2, wc = wid & 3, fr = lane & 15, fq = lane >> 4;
    const int K = g.K, nt = K / BK;
    unsigned voffA[2], voffB[2];
#pragma unroll
    for (int i = 0; i < 2; ++i) { int R, C; stage_rc(tid * 16 + i * 8192, R, C); const int Rb = Epi::PERM ? ((R & ~31) + perm32(R & 31)) : R;
        voffA[i] = (unsigned)(R * g.lda + C) * 2u; voffB[i] = (unsigned)(Rb * g.ldb + C) * 2u; }
    const size_t kstep = (size_t)(BK * 2);
    const size_t hstepA = (size_t)HALF * g.lda * 2, hstepB = (size_t)HALF * g.ldb * 2;
    const size_t tstepA = 2 * hstepA, tstepB = 2 * hstepB;
    const unsigned ldsw = (unsigned)wid * 1024u;
    const int aoff = lds_byte(wr * 64 + fr, fq * 8), boff = lds_byte(wc * 32 + fr, fq * 8);
#define PG8_SA(b, h) (((b) * 2 + (h)) * HTB)
#define PG8_SB(b, h) ((4 + (b) * 2 + (h)) * HTB)
#define PG8_STAGE(bufoff, gbase, voff) do { _Pragma("unroll") for (int _i = 0; _i < 2; ++_i) \
        __builtin_amdgcn_global_load_lds((const unsigned*)((const char*)(gbase) + (voff)[_i]), (PG8_LAS unsigned*)(lds + (bufoff) + ldsw + _i * 8192), 16, 0, 0); } while (0)
#define PG8_LDA(dst, b, h) do { _Pragma("unroll") for (int m = 0; m < 4; ++m) _Pragma("unroll") for (int k = 0; k < 2; ++k) dst[m][k] = *(const PG8_LAS bf16x8*)(lds + PG8_SA(b, h) + aoff + m * 2048 + k * 1024); } while (0)
#define PG8_LDB(dst, b, h) do { _Pragma("unroll") for (int n = 0; n < 2; ++n) _Pragma("unroll") for (int k = 0; k < 2; ++k) dst[n][k] = *(const PG8_LAS bf16x8*)(lds + PG8_SB(b, h) + boff + n * 2048 + k * 1024); } while (0)
#define PG8_MMA(ai, bj, At, Bt) do { __builtin_amdgcn_s_setprio(1); _Pragma("unroll") for (int m = 0; m < 4; ++m) _Pragma("unroll") for (int n = 0; n < 2; ++n) _Pragma("unroll") for (int k = 0; k < 2; ++k) \
        acc[ai][bj][m][n] = __builtin_amdgcn_mfma_f32_16x16x32_bf16(Bt[n][k], At[m][k], acc[ai][bj][m][n], 0, 0, 0); __builtin_amdgcn_s_setprio(0); } while (0)
#define PG8_WAIT_V(n) asm volatile("s_waitcnt vmcnt(" #n ")" ::: "memory")
#define PG8_WAIT_L(n) asm volatile("s_waitcnt lgkmcnt(" #n ")" ::: "memory")
#define PG8_BAR __builtin_amdgcn_s_barrier()
#define PG8_SCHED __builtin_amdgcn_sched_barrier(0)
    Unit cur, nxt; int ui = 0;
    if (!S.next(0, cur)) return;
    f32x4 acc[2][2][4][2];
#pragma unroll
    for (int a = 0; a < 2; ++a)
#pragma unroll
        for (int b = 0; b < 2; ++b)
#pragma unroll
            for (int m = 0; m < 4; ++m)
#pragma unroll
                for (int n = 0; n < 2; ++n) acc[a][b][m][n] = (f32x4){0.f, 0.f, 0.f, 0.f};
    bf16x8 At[4][2], B0[2][2], B1[2][2];
    const char* cA = (const char*)g.A + (size_t)cur.pm * tstepA; const char* cB = (const char*)g.Bt + (size_t)cur.pn * tstepB;
    S.a_ready(cur);
    if constexpr (SP2) {
        PG8_STAGE(PG8_SB(0, 0), cB, voffB); PG8_STAGE(PG8_SB(0, 1), cB + hstepB, voffB); PG8_STAGE(PG8_SA(0, 0), cA, voffA); PG8_STAGE(PG8_SA(0, 1), cA + hstepA, voffA);
        if (wr == 1) PG8_BAR;
        PG8_WAIT_V(2); PG8_BAR;
        PG8_STAGE(PG8_SB(1, 0), cB + kstep, voffB); PG8_STAGE(PG8_SA(1, 0), cA + kstep, voffA); PG8_STAGE(PG8_SB(1, 1), cB + hstepB + kstep, voffB);
        PG8_WAIT_V(6); PG8_BAR;
    } else {
        PG8_STAGE(PG8_SB(0, 0), cB, voffB); PG8_STAGE(PG8_SA(0, 0), cA, voffA); PG8_STAGE(PG8_SB(0, 1), cB + hstepB, voffB); PG8_STAGE(PG8_SA(0, 1), cA + hstepA, voffA);
        if (wr == 1) PG8_BAR;
        PG8_WAIT_V(4); PG8_BAR;
        PG8_STAGE(PG8_SB(1, 0), cB + kstep, voffB); PG8_STAGE(PG8_SA(1, 0), cA + kstep, voffA); PG8_STAGE(PG8_SB(1, 1), cB + hstepB + kstep, voffB);
        PG8_WAIT_V(6); PG8_BAR;
    }
    for (;;) {
        const bool has_next = S.next(ui + 1, nxt);
        const char* nA = has_next ? (const char*)g.A + (size_t)nxt.pm * tstepA : cA; const char* nB = has_next ? (const char*)g.Bt + (size_t)nxt.pn * tstepB : cB;
        for (int t = 0; t < nt; t += 2) {
            const bool last = (t == nt - 2);
            const char* a1 = cA + (size_t)(t + 1) * kstep;
            const char* a2 = last ? nA : cA + (size_t)(t + 2) * kstep; const char* b2 = last ? nB : cB + (size_t)(t + 2) * kstep;
            const char* a3 = a2 + kstep; const char* b3 = b2 + kstep;
            if (last && has_next) S.a_ready(nxt);
            if constexpr (SP2) {
            PG8_LDB(B0, 0, 0); PG8_LDB(B1, 0, 1); PG8_SCHED; PG8_LDA(At, 0, 0); PG8_STAGE(PG8_SA(1, 1), a1 + hstepA, voffA);
            PG8_WAIT_V(8); PG8_WAIT_L(0); PG8_BAR; PG8_MMA(0, 0, At, B0); PG8_MMA(0, 1, At, B1); PG8_BAR; PG8_SCHED;
            PG8_LDA(At, 0, 1); PG8_STAGE(PG8_SB(0, 0), b2, voffB); PG8_STAGE(PG8_SB(0, 1), b2 + hstepB, voffB); PG8_STAGE(PG8_SA(0, 0), a2, voffA);
            PG8_WAIT_V(8); PG8_WAIT_L(0); PG8_BAR; PG8_MMA(1, 0, At, B0); PG8_MMA(1, 1, At, B1); PG8_BAR; PG8_SCHED;
            PG8_LDB(B0, 1, 0); PG8_LDB(B1, 1, 1); PG8_SCHED; PG8_LDA(At, 1, 0); PG8_STAGE(PG8_SA(0, 1), a2 + hstepA, voffA);
            PG8_WAIT_V(8); PG8_WAIT_L(0); PG8_BAR; PG8_MMA(0, 0, At, B0); PG8_MMA(0, 1, At, B1); PG8_BAR; PG8_SCHED;
            PG8_LDA(At, 1, 1); PG8_STAGE(PG8_SB(1, 0), b3, voffB); PG8_STAGE(PG8_SB(1, 1), b3 + hstepB, voffB); PG8_STAGE(PG8_SA(1, 0), a3, voffA);
            PG8_WAIT_V(8); PG8_WAIT_L(0); PG8_BAR; PG8_MMA(1, 0, At, B0); PG8_MMA(1, 1, At, B1); PG8_BAR; PG8_SCHED;
            } else {
            PG8_LDB(B0, 0, 0); PG8_SCHED; PG8_LDA(At, 0, 0); PG8_STAGE(PG8_SA(1, 1), a1 + hstepA, voffA);
            PG8_WAIT_L(8); PG8_BAR; PG8_WAIT_L(0); PG8_MMA(0, 0, At, B0); PG8_BAR; PG8_SCHED;
            PG8_LDB(B1, 0, 1); PG8_STAGE(PG8_SB(0, 0), b2, voffB);
            PG8_BAR; PG8_WAIT_L(0); PG8_MMA(0, 1, At, B1); PG8_BAR;
            PG8_LDA(At, 0, 1); PG8_STAGE(PG8_SA(0, 0), a2, voffA);
            PG8_BAR; PG8_WAIT_L(0); PG8_MMA(1, 0, At, B0); PG8_BAR; PG8_SCHED;
            PG8_STAGE(PG8_SB(0, 1), b2 + hstepB, voffB);
            PG8_WAIT_V(6); PG8_BAR; PG8_MMA(1, 1, At, B1); PG8_BAR;
            PG8_LDB(B0, 1, 0); PG8_SCHED; PG8_LDA(At, 1, 0); PG8_STAGE(PG8_SA(0, 1), a2 + hstepA, voffA);
            PG8_WAIT_L(8); PG8_BAR; PG8_WAIT_L(0); PG8_MMA(0, 0, At, B0); PG8_BAR; PG8_SCHED;
            PG8_LDB(B1, 1, 1); PG8_STAGE(PG8_SB(1, 0), b3, voffB);
            PG8_BAR; PG8_WAIT_L(0); PG8_MMA(0, 1, At, B1); PG8_BAR;
            PG8_LDA(At, 1, 1); PG8_STAGE(PG8_SA(1, 0), a3, voffA);
            PG8_BAR; PG8_WAIT_L(0); PG8_MMA(1, 0, At, B0); PG8_BAR; PG8_SCHED;
            PG8_STAGE(PG8_SB(1, 1), b3 + hstepB, voffB);
            PG8_WAIT_V(6); PG8_BAR; PG8_MMA(1, 1, At, B1); PG8_BAR;
            }
        }
        if constexpr (ALIGN_EPI) { if (wr == 0) PG8_BAR; }
        E(acc, cur, wr, wc, fr, fq); S.done(cur);
        if (!has_next) break;
#pragma unroll
        for (int a = 0; a < 2; ++a)
#pragma unroll
            for (int b = 0; b < 2; ++b)
#pragma unroll
                for (int m = 0; m < 4; ++m)
#pragma unroll
                    for (int n = 0; n < 2; ++n) acc[a][b][m][n] = (f32x4){0.f, 0.f, 0.f, 0.f};
        cur = nxt; cA = nA; cB = nB; ++ui;
        if constexpr (ALIGN_EPI) { if (wr == 1) PG8_BAR; }
    }
    PG8_WAIT_V(0);
    if constexpr (!ALIGN_EPI) { if (wr == 0) PG8_BAR; }
    PG8_BAR;
#undef PG8_SA
#undef PG8_SB
#undef PG8_STAGE
#undef PG8_LDA
#undef PG8_LDB
#undef PG8_MMA
#undef PG8_WAIT_V
#undef PG8_WAIT_L
#undef PG8_BAR
#undef PG8_SCHED
}
}

constexpr int NB = 8, SEQ = 2048, D = 1024, DEPTH = 4, M = NB * SEQ;
constexpr int NP = 7168;
constexpr int C_U = 0, C_MQ = 512, C_MK = 1024, C_MV = 1536, C_MO = 2048, C_AQ = 2560, C_AK = 3072, C_AV = 3584, C_G = 4096;
constexpr int C_YSSM = C_AK, C_YML = C_MO, C_YMOBA = C_AQ;
constexpr int FF = 4096;
constexpr float RMS_EPS = 1e-6f;
constexpr int SSM_L = 64, SSM_NC = SEQ / SSM_L;
constexpr int ML_L = 128, ML_NC = SEQ / ML_L;
constexpr int DC_ROWS = 129, DC_UNIT = 136 * 128;

constexpr size_t MiB = 1u << 20;
constexpr size_t WS_CTL = 0, CTL_ZERO_BYTES = 1 * MiB;
constexpr size_t WS_WT = 2 * MiB, WT_LAYER = 35 * MiB + MiB / 2;
constexpr size_t WT_IN = 0, WT_GLU = 14 * MiB, WT_BR = 14 * MiB + MiB / 2, WT_OUT = 17 * MiB + MiB / 2, WT_FF1 = 19 * MiB + MiB / 2, WT_FF2 = 27 * MiB + MiB / 2;
constexpr size_t WS_XB = 144 * MiB;
constexpr size_t WS_PROJ = 176 * MiB;
constexpr size_t WS_DC = 400 * MiB;
constexpr size_t WS_SLOC = 417 * MiB;
constexpr size_t WS_SMALL = 421 * MiB;
constexpr size_t SM_RSTD = 0, SM_G8 = 64 * 1024, SM_KM = SM_G8 + 512 * 1024, SM_STATS = SM_KM + 128 * 1024, SM_MPREV = SM_STATS + 4096, SM_WG8 = SM_MPREV + 4096;
constexpr size_t WS_TAB = 424 * MiB, TAB_KT = 0, TAB_W1 = 1 * MiB, TAB_W2 = 9 * MiB;
constexpr size_t WS_END = 441 * MiB;
static_assert(WS_WT + 4 * WT_LAYER <= WS_XB && WS_XB + (size_t)M * D * 2 <= WS_PROJ && WS_PROJ + (size_t)M * NP * 2 <= WS_DC && WS_DC + (size_t)512 * DC_UNIT * 2 <= WS_SLOC && WS_SLOC + 4 * MiB <= WS_SMALL && SM_WG8 + 4 * 8 * 1024 * 4 <= 3 * MiB, "ws map");
constexpr size_t PROJ_TMP1 = 0, PROJ_HFF = 0, PROJ_TMP2 = 128 * MiB;
constexpr int CW_BAR = 4096;

constexpr int NWAVES = 8;
constexpr int RING_OFF = 0, RING_BYTES = 131072;
constexpr int LDSCTL_OFF = 147456 - 512, MISC_OFF = LDSCTL_OFF + 320;
constexpr int LDS_BYTES = 147456;

#define GAS __attribute__((address_space(1)))
#define LAS __attribute__((address_space(3)))
typedef unsigned short bf16;
typedef unsigned v4u __attribute__((ext_vector_type(4)));
typedef unsigned v2u __attribute__((ext_vector_type(2)));
typedef float f32x4 __attribute__((ext_vector_type(4)));
typedef float f32x16 __attribute__((ext_vector_type(16)));
typedef short bf16x8 __attribute__((ext_vector_type(8)));
typedef short s16x4 __attribute__((ext_vector_type(4)));
typedef GAS unsigned gu32;
#define RLX_AGENT __ATOMIC_RELAXED, __HIP_MEMORY_SCOPE_AGENT
#define LDS_WAIT() asm volatile("s_waitcnt lgkmcnt(0)" ::: "memory")
__device__ __forceinline__ unsigned f2bf(float f) { unsigned u = __builtin_bit_cast(unsigned, f); return (u + 0x7fffu + ((u >> 16) & 1u)) >> 16; }
__device__ __forceinline__ unsigned pk2(float lo, float hi) { return pg8::cvt_pk_bf16(lo, hi); }
__device__ __forceinline__ float bf2f(unsigned short b) { return __uint_as_float((unsigned)b << 16); }
using pg8::bflo; using pg8::bfhi; using pg8::sigmoidf_;
__device__ __forceinline__ int crow(int r, int hi) { return (r & 3) + 8 * (r >> 2) + 4 * hi; }
#define MFMA32(a, b, c) __builtin_amdgcn_mfma_f32_32x32x16_bf16((a), (b), (c), 0, 0, 0)

#define XB_TMO      128
#define XB_XCNT(j)  (256  + 64 * (j))
#define XB_XSUB(j)  (1280 + 64 * (j))
#define XB_XGEN(j)  (2304 + 64 * (j))
#define XB_TOP      3328
#define XB_TOPGEN   3392
#define XCD_BAR_WORDS 3456
#define XB_SPIN_CAP (1u << 18)
__device__ __forceinline__ unsigned xb_ld(unsigned* p)              { return __hip_atomic_load(p, __ATOMIC_RELAXED, __HIP_MEMORY_SCOPE_AGENT); }
__device__ __forceinline__ unsigned xb_add(unsigned* p, unsigned v) { return __hip_atomic_fetch_add(p, v, __ATOMIC_RELAXED, __HIP_MEMORY_SCOPE_AGENT); }
__device__ __forceinline__ unsigned xb_xcc_id() { return (unsigned)__builtin_amdgcn_s_getreg((3 << 11) | 20) & 0xFu; }
#define XB_SPIN(cond, bar) do { unsigned _sp = 0; while (cond) { __builtin_amdgcn_s_sleep(1); \
    if ((++_sp & 255u) == 0u) { if (xb_ld(&(bar)[XB_TMO])) break; if (_sp > XB_SPIN_CAP) { atomicAdd(&(bar)[XB_TMO], 1u); break; } } } } while (0)
struct XcdBarrier { unsigned* bar; unsigned x; volatile LAS unsigned* st; };
__device__ __forceinline__ XcdBarrier xcd_barrier_post(unsigned* bar, volatile LAS unsigned* st) {
    XcdBarrier b; b.bar = bar; b.x = xb_xcc_id(); b.st = st;
    if (threadIdx.x == 0) (void)xb_add(&bar[XB_XCNT(b.x)], 1u);
    return b;
}
__device__ __forceinline__ void xcd_barrier_complete(unsigned* bar, unsigned x, unsigned& nloc, unsigned& nx) {
    const unsigned G = gridDim.x * gridDim.y * gridDim.z;
    unsigned sum, cnt, mine, sp = 0u;
    for (;;) {
        sum = 0u; cnt = 0u; mine = 0u;
#pragma unroll
        for (unsigned j = 0; j < 16; ++j) { const unsigned c = xb_ld(&bar[XB_XCNT(j)]); sum += c; cnt += (c > 0u) ? 1u : 0u; mine = (j == x) ? c : mine; }
        if (sum == G) break;
        __builtin_amdgcn_s_sleep(1);
        if ((++sp & 255u) == 0u) { if (xb_ld(&bar[XB_TMO])) break; if (sp > XB_SPIN_CAP) { atomicAdd(&bar[XB_TMO], 1u); break; } }
    }
    nloc = mine > 0u ? mine : 1u; nx = cnt > 0u ? cnt : 1u;
}
__device__ __forceinline__ void xcd_barrier(const XcdBarrier& b) {
    asm volatile("s_waitcnt vmcnt(0)" ::: "memory");
    __syncthreads();
    if (threadIdx.x == 0) {
        unsigned* bar = b.bar;
        __builtin_amdgcn_s_waitcnt(0);
        unsigned nloc = b.st[0], nx = b.st[1];
        if (nloc == 0u) { xcd_barrier_complete(bar, b.x, nloc, nx); b.st[0] = nloc; b.st[1] = nx; }
        const unsigned old = xb_add(&bar[XB_XSUB(b.x)], 1u);
        const unsigned gen = old / nloc;
        if (old + 1u == (gen + 1u) * nloc) {
            __builtin_amdgcn_fence(__ATOMIC_RELEASE, "agent");
            asm volatile("s_waitcnt vmcnt(0)" ::: "memory");
            const unsigned og = xb_add(&bar[XB_TOP], 1u);
            const unsigned tg = og / nx;
            if (og + 1u == (tg + 1u) * nx) xb_add(&bar[XB_TOPGEN], 1u);
            else XB_SPIN(xb_ld(&bar[XB_TOPGEN]) == tg, bar);
            __builtin_amdgcn_fence(__ATOMIC_ACQUIRE, "agent");
            xb_add(&bar[XB_XGEN(b.x)], 1u);
            asm volatile("s_waitcnt vmcnt(0)" ::: "memory");
        } else {
            XB_SPIN(xb_ld(&bar[XB_XGEN(b.x)]) == gen, bar);
            __builtin_amdgcn_fence(__ATOMIC_ACQUIRE, "agent");
            asm volatile("s_waitcnt vmcnt(0)" ::: "memory");
        }
    }
    __syncthreads();
}

struct Args { const float* in[26]; float* out; unsigned char* ws; int s_lo, s_hi; };
struct Frame {
    LAS unsigned char* lds;
    int tid, lane, wave, G, wg;
    const float* const* in; float* out; unsigned char* ws;
    bf16* XB; bf16* PROJ; bf16* DC; float* SLOC; float* RSTD; float* G8; float* KM; float* STATS; float* MPREV; float* WG8;
};
__device__ __forceinline__ float wave_sum(float v) {
#pragma unroll
    for (int o = 1; o < 64; o <<= 1) v += __shfl_xor(v, o);
    return v;
}

__device__ __forceinline__ void transpose_item(const float* W, int spitch, int scol, bf16* WT, int dpitch, int dk0, const float* gain, LAS float* scr, int kb, int nb, int lane) {
    const int k0 = 64 * kb, n0 = 32 * nb;
#pragma unroll 8
    for (int i = 0; i < 32; ++i) { const int kk = 2 * i + (lane >> 5); float v = W[(size_t)(k0 + kk) * spitch + scol + n0 + (lane & 31)]; if (gain) v *= gain[k0 + kk]; scr[kk * 33 + (lane & 31)] = v; }
    LDS_WAIT(); asm volatile("" ::: "memory");
    const int c = lane & 7;
#pragma unroll
    for (int j = 0; j < 4; ++j) { const int n = (lane >> 3) + 8 * j; const LAS float* s = scr + (8 * c) * 33 + n;
        v4u o; o.x = pk2(s[0 * 33], s[1 * 33]); o.y = pk2(s[2 * 33], s[3 * 33]); o.z = pk2(s[4 * 33], s[5 * 33]); o.w = pk2(s[6 * 33], s[7 * 33]);
        *(GAS v4u*)(WT + (size_t)(n0 + n) * dpitch + dk0 + k0 + 8 * c) = o; }
    LDS_WAIT(); asm volatile("" ::: "memory");
}
__device__ __forceinline__ void p_convert(Frame& F) {
    LAS float* scr = (LAS float*)(F.lds + RING_OFF + F.wave * 16384);
    const int gw = F.wg * NWAVES + F.wave, NGW = F.G * NWAVES;
    constexpr int I_IN = 16 * 224, I_GLU = 8 * 16, I_BR = 8 * 32, I_OUT = 16 * 32, I_FF1 = 16 * 128, I_FF2 = 64 * 32;
    constexpr int I_LAYER = I_IN + I_GLU + 3 * I_BR + I_OUT + I_FF1 + I_FF2;
    for (int it = gw; it < DEPTH * I_LAYER; it += NGW) {
        const int l = it / I_LAYER; int r = it % I_LAYER;
        unsigned char* wl = F.ws + WS_WT + (size_t)l * WT_LAYER;
        if (r < I_IN) { const int kb = r / 224, nb = r % 224; const int n0 = nb * 32; const int scol = (n0 >= 2560) ? 8 : 0;
            transpose_item(F.in[1] + (size_t)l * 1024 * 7176, 7176, scol, (bf16*)(wl + WT_IN), 1024, 0, F.in[22] + l * 1024, scr, kb, nb, F.lane); continue; } r -= I_IN;
        if (r < I_GLU) { transpose_item(F.in[11] + (size_t)l * 512 * 512, 512, 0, (bf16*)(wl + WT_GLU), 512, 0, nullptr, scr, r / 16, r % 16, F.lane); continue; } r -= I_GLU;
        if (r < 3 * I_BR) { const int br = r / I_BR, rr = r % I_BR; const float* src = F.in[16 + br] + (size_t)l * 512 * 1024;
            transpose_item(src, 1024, 0, (bf16*)(wl + WT_BR), 1536, 512 * br, nullptr, scr, rr / 32, rr % 32, F.lane); continue; } r -= 3 * I_BR;
        if (r < I_OUT) { transpose_item(F.in[19] + (size_t)l * 1024 * 1024, 1024, 0, (bf16*)(wl + WT_OUT), 1024, 0, nullptr, scr, r / 32, r % 32, F.lane); continue; } r -= I_OUT;
        if (r < I_FF1) { transpose_item(F.in[20] + (size_t)l * 1024 * 4096, 4096, 0, (bf16*)(wl + WT_FF1), 1024, 0, F.in[24] + l * 1024, scr, r / 128, r % 128, F.lane); continue; } r -= I_FF1;
        transpose_item(F.in[21] + (size_t)l * 4096 * 1024, 1024, 0, (bf16*)(wl + WT_FF2), 4096, 0, nullptr, scr, r / 32, r % 32, F.lane);
    }
    for (int i = gw * 64 + F.lane; i < DEPTH * 8 * 1024; i += NGW * 64) { const int l = i >> 13, j = (i >> 10) & 7, k = i & 1023;
        F.WG8[i] = F.in[1][((size_t)l * 1024 + k) * 7176 + 2560 + j] * F.in[22][l * 1024 + k]; }
}

__device__ __forceinline__ void p_rows(Frame& F, const float* xold, const float* tmp, const float* gpost, bool upd, bool next, int g8l, float* xout, bf16* xbout, float* rstdout, float* g8out) {
    const int gw = F.wg * NWAVES + F.wave, NGW = F.G * NWAVES;
    for (int m = gw; m < M; m += NGW) {
        const GAS f32x4* xr = (const GAS f32x4*)(xold + (size_t)m * D) + F.lane;
        f32x4 v[4];
#pragma unroll
        for (int j = 0; j < 4; ++j) v[j] = xr[64 * j];
        if (upd) {
            const GAS f32x4* tr = (const GAS f32x4*)(tmp + (size_t)m * D) + F.lane; f32x4 t[4]; float s = 0.f;
#pragma unroll
            for (int j = 0; j < 4; ++j) { t[j] = tr[64 * j]; s += (t[j].x * t[j].x + t[j].y * t[j].y) + (t[j].z * t[j].z + t[j].w * t[j].w); }
            const float rs = 1.0f / sqrtf(wave_sum(s) * (1.f / D) + RMS_EPS);
            GAS f32x4* orow = (GAS f32x4*)(xout + (size_t)m * D) + F.lane;
#pragma unroll
            for (int j = 0; j < 4; ++j) { const f32x4 gp = *((const GAS f32x4*)gpost + F.lane + 64 * j); v[j] = v[j] + t[j] * rs * gp; orow[64 * j] = v[j]; }
        }
        if (next) {
            float s2 = 0.f;
#pragma unroll
            for (int j = 0; j < 4; ++j) s2 += (v[j].x * v[j].x + v[j].y * v[j].y) + (v[j].z * v[j].z + v[j].w * v[j].w);
            const float rstd = 1.0f / sqrtf(wave_sum(s2) * (1.f / D) + RMS_EPS);
            if (F.lane == 0) rstdout[m] = rstd;
            GAS v2u* o8 = (GAS v2u*)(xbout + (size_t)m * D) + F.lane;
#pragma unroll
            for (int j = 0; j < 4; ++j) { v2u w; w.x = pk2(v[j].x, v[j].y); w.y = pk2(v[j].z, v[j].w); o8[64 * j] = w; }
            if (g8l >= 0) {
                float myv = 0.f;
#pragma unroll
                for (int q = 0; q < 8; ++q) { const GAS f32x4* wr = (const GAS f32x4*)(F.WG8 + ((size_t)g8l * 8 + q) * 1024) + F.lane; float d = 0.f;
#pragma unroll
                    for (int j = 0; j < 4; ++j) { const f32x4 w = wr[64 * j]; d += (v[j].x * w.x + v[j].y * w.y) + (v[j].z * w.z + v[j].w * w.w); }
                    d = wave_sum(d) * rstd; if (F.lane == q) myv = d; }
                if (F.lane < 8) g8out[(size_t)m * 8 + F.lane] = myv;
            }
        }
    }
}

struct SsmCoef { float ar, ai; float bbr[16], bbi[16]; };
__device__ __forceinline__ void ssm_coef(Frame& F, int l, int g, int p, SsmCoef& c) {
    const float lr = F.in[3][(l * 32 + g) * 64 + p], li = F.in[4][(l * 32 + g) * 64 + p];
    const float dt = expf(F.in[5][l * 32 + g]);
    const float dec = expf(dt * lr); const float ang = dt * li;
    c.ar = dec * cosf(ang); c.ai = dec * sinf(ang);
    const float den = lr * lr + li * li, nr = c.ar - 1.0f, ni = c.ai;
    const float fr = (nr * lr + ni * li) / den, fi = (ni * lr - nr * li) / den;
    const GAS f32x4* br = (const GAS f32x4*)(F.in[6] + ((size_t)(l * 32 + g) * 64 + p) * 16);
    const GAS f32x4* bi = (const GAS f32x4*)(F.in[7] + ((size_t)(l * 32 + g) * 64 + p) * 16);
#pragma unroll
    for (int q = 0; q < 4; ++q) { const f32x4 r = br[q], i = bi[q];
#pragma unroll
        for (int e = 0; e < 4; ++e) { c.bbr[4 * q + e] = fr * r[e] - fi * i[e]; c.bbi[4 * q + e] = fr * i[e] + fi * r[e]; } }
}
__device__ __forceinline__ void ssm_bu(const SsmCoef& c, const bf16* urow, float& bur, float& bui) {
    const v4u u0 = *(const GAS v4u*)urow, u1 = *((const GAS v4u*)urow + 1);
    const unsigned w[8] = {u0.x, u0.y, u0.z, u0.w, u1.x, u1.y, u1.z, u1.w};
    float r = 0.f, i = 0.f;
#pragma unroll
    for (int q = 0; q < 8; ++q) { const float a = bflo(w[q]), b = bfhi(w[q]); r += c.bbr[2 * q] * a + c.bbr[2 * q + 1] * b; i += c.bbi[2 * q] * a + c.bbi[2 * q + 1] * b; }
    bur = r; bui = i;
}
__device__ __forceinline__ float gelu_tanh(float x) { const float u2 = 1.5957691216057308f * (x + 0.044715f * x * x * x); return x / (1.0f + __expf(-u2)); }
__device__ __forceinline__ void ssm_pow(Frame& F, int l, int g, int p, float n, float& pr, float& pi) {
    const float lr = F.in[3][(l * 32 + g) * 64 + p], li = F.in[4][(l * 32 + g) * 64 + p];
    const float dt = expf(F.in[5][l * 32 + g]);
    const float mag = expf(n * dt * lr), ang = n * dt * li;
    pr = mag * cosf(ang); pi = mag * sinf(ang);
}
__device__ __forceinline__ void p_ssm_tables(Frame& F, int l) {
    const int gw = F.wg * NWAVES + F.wave, NGW = F.G * NWAVES, lane = F.lane;
    bf16* KT = (bf16*)(F.ws + WS_TAB + TAB_KT); bf16* W1 = (bf16*)(F.ws + WS_TAB + TAB_W1); bf16* W2 = (bf16*)(F.ws + WS_TAB + TAB_W2);
    LAS float* EL = (LAS float*)(F.lds + F.wave * 16384);
    for (int it = gw; it < 32 * 64; it += NGW) { const int g = it >> 6, j = it & 63;
        SsmCoef cf; ssm_coef(F, l, g, lane, cf);
        float pr, pi; ssm_pow(F, l, g, lane, (float)j, pr, pi);
#pragma unroll
        for (int h = 0; h < 16; ++h) { EL[lane * 16 + h] = pr * cf.bbr[h] - pi * cf.bbi[h]; EL[1024 + lane * 16 + h] = pr * cf.bbi[h] + pi * cf.bbr[h]; }
        LDS_WAIT(); asm volatile("" ::: "memory");
        const int hp = lane >> 2, hq = lane & 3; float k4[4] = {0.f, 0.f, 0.f, 0.f};
        const float* cr = F.in[8] + ((size_t)(l * 32 + g) * 16 + hp) * 64; const float* ci = F.in[9] + ((size_t)(l * 32 + g) * 16 + hp) * 64;
#pragma unroll 2
        for (int p = 0; p < 64; ++p) { const float c_r = cr[p], c_i = ci[p]; const f32x4 er = *(const LAS f32x4*)(EL + p * 16 + hq * 4), ei = *(const LAS f32x4*)(EL + 1024 + p * 16 + hq * 4);
#pragma unroll
            for (int i = 0; i < 4; ++i) k4[i] += c_r * er[i] - c_i * ei[i]; }
        if (j == 0) {
#pragma unroll
            for (int i = 0; i < 4; ++i) if (hq * 4 + i == hp) k4[i] += F.in[10][l * 512 + g * 16 + hp]; }
        v2u w; w.x = pk2(k4[0], k4[1]); w.y = pk2(k4[2], k4[3]);
        *(GAS v2u*)(KT + ((size_t)(g * 64 + j) * 16 + hp) * 16 + hq * 4) = w;
        LDS_WAIT(); asm volatile("" ::: "memory");
    }
    for (int it = gw; it < 32 * 8; it += NGW) { const int g = it >> 3, tb = it & 7;
        SsmCoef cf; ssm_coef(F, l, g, lane, cf);
        { float pr, pi; ssm_pow(F, l, g, lane, (float)(63 - (tb * 8 + 7)), pr, pi);
#pragma unroll 1
          for (int s = 7; s >= 0; --s) { const int tau = tb * 8 + s;
            unsigned wr_[8], wi_[8];
#pragma unroll
            for (int h = 0; h < 16; h += 2) { wr_[h >> 1] = pk2(pr * cf.bbr[h] - pi * cf.bbi[h], pr * cf.bbr[h + 1] - pi * cf.bbi[h + 1]); wi_[h >> 1] = pk2(pr * cf.bbi[h] + pi * cf.bbr[h], pr * cf.bbi[h + 1] + pi * cf.bbr[h + 1]); }
            GAS v4u* dr = (GAS v4u*)(W1 + ((size_t)(g * 128 + lane) * 1024 + tau * 16)); GAS v4u* di = (GAS v4u*)(W1 + ((size_t)(g * 128 + 64 + lane) * 1024 + tau * 16));
            dr[0] = (v4u){wr_[0], wr_[1], wr_[2], wr_[3]}; dr[1] = (v4u){wr_[4], wr_[5], wr_[6], wr_[7]};
            di[0] = (v4u){wi_[0], wi_[1], wi_[2], wi_[3]}; di[1] = (v4u){wi_[4], wi_[5], wi_[6], wi_[7]};
            const float nr = pr * cf.ar - pi * cf.ai, ni = pr * cf.ai + pi * cf.ar; pr = nr; pi = ni; } }
        { float pr, pi; ssm_pow(F, l, g, lane, (float)(tb * 8 + 1), pr, pi);
#pragma unroll 1
          for (int s = 0; s < 8; ++s) { const int t = tb * 8 + s;
#pragma unroll 2
            for (int hp = 0; hp < 16; ++hp) { const float c_r = F.in[8][((size_t)(l * 32 + g) * 16 + hp) * 64 + lane], c_i = F.in[9][((size_t)(l * 32 + g) * 16 + hp) * 64 + lane];
                bf16* row = W2 + ((size_t)g * 1024 + t * 16 + hp) * 128;
                row[lane] = (bf16)f2bf(c_r * pr - c_i * pi); row[64 + lane] = (bf16)f2bf(-(c_r * pi + c_i * pr)); }
            const float nr = pr * cf.ar - pi * cf.ai, ni = pr * cf.ai + pi * cf.ar; pr = nr; pi = ni; } }
    }
}
constexpr int SS_UL = 0, SS_X = 65536, SS_SI = 65536 + 49152;
__device__ __forceinline__ void p_ssm(Frame& F, int l, bf16* ybase, int ypitch) {
    const int tid = F.tid, lane = F.lane, r32 = lane & 31, hf = lane >> 5, w = F.wave;
    LAS unsigned char* UL = F.lds + SS_UL; LAS unsigned char* XR = F.lds + SS_X; LAS bf16* SI = (LAS bf16*)(F.lds + SS_SI);
    const bf16* KT = (const bf16*)(F.ws + WS_TAB + TAB_KT); const bf16* W1 = (const bf16*)(F.ws + WS_TAB + TAB_W1); const bf16* W2 = (const bf16*)(F.ws + WS_TAB + TAB_W2);
    for (int u = F.wg; u < 256; u += F.G) { const int g = (u & 7) * 4 + ((u >> 3) & 3), b = u >> 5;
        __syncthreads();
#pragma unroll
        for (int it = 0; it < 8; ++it) { const int piece = tid + 512 * it, c = piece & 31, hp = (piece >> 5) & 1, tau = piece >> 6;
            *(LAS v4u*)(UL + piece * 16) = *(const GAS v4u*)(F.PROJ + ((size_t)b * SEQ + c * SSM_L + tau) * NP + C_U + g * 16 + hp * 8); }
        __syncthreads();
        { const int mb = w & 3, th = w >> 2; f32x16 acc;
#pragma unroll
          for (int i = 0; i < 16; ++i) acc[i] = 0.f;
          const bf16* wrow = W1 + ((size_t)(g * 128 + mb * 32 + r32) * 1024 + 8 * hf);
#pragma unroll 8
          for (int t = 0; t < 32; ++t) { const int tau = th * 32 + t; const bf16x8 a = *(const GAS bf16x8*)(wrow + tau * 16); const bf16x8 bb = *(const LAS bf16x8*)(UL + tau * 1024 + hf * 512 + r32 * 16);
              acc = MFMA32(a, bb, acc); }
          LAS float* SLP = (LAS float*)XR + th * (32 * 132);
#pragma unroll
          for (int i = 0; i < 16; i += 4) { f32x4 v = {acc[i], acc[i + 1], acc[i + 2], acc[i + 3]}; *(LAS f32x4*)(SLP + r32 * 132 + mb * 32 + crow(i, hf)) = v; } }
        __syncthreads();
        if (tid < 64) { SsmCoef cf; ssm_coef(F, l, g, tid, cf); float pr = cf.ar, pi = cf.ai;
#pragma unroll
            for (int q = 0; q < 6; ++q) { const float nr = pr * pr - pi * pi, ni = 2.f * pr * pi; pr = nr; pi = ni; }
            const LAS float* S0 = (const LAS float*)XR; const LAS float* S1 = S0 + 32 * 132; float sr = 0.f, si = 0.f;
            for (int c = 0; c < 32; ++c) { SI[c * 136 + tid] = (bf16)f2bf(sr); SI[c * 136 + 64 + tid] = (bf16)f2bf(si);
                const float lr = S0[c * 132 + tid] + S1[c * 132 + tid], li = S0[c * 132 + 64 + tid] + S1[c * 132 + 64 + tid];
                const float nr = pr * sr - pi * si + lr, ni = pr * si + pi * sr + li; sr = nr; si = ni; } }
        __syncthreads();
#pragma unroll
        for (int it = 0; it < 4; ++it) { const int piece = tid + 512 * it, row = piece >> 1, half = piece & 1;
            *(LAS v4u*)(XR + row * 48 + half * 16) = *(const GAS v4u*)(KT + (size_t)g * 16384 + row * 16 + half * 8); }
        __syncthreads();
        { const int ib[4] = {w, 15 - w, 16 + w, 31 - w}; f32x16 acc[4];
#pragma unroll
          for (int k = 0; k < 4; ++k)
#pragma unroll
              for (int i = 0; i < 16; ++i) acc[k][i] = 0.f;
          const int dt = r32 >> 4, hp = r32 & 15; const LAS unsigned char* kbase = XR + hp * 48 + hf * 16;
          const int tmax = 2 * ib[3] + 1;
#pragma unroll 2
          for (int tau = 0; tau <= tmax; ++tau) { const bf16x8 bb = *(const LAS bf16x8*)(UL + tau * 1024 + hf * 512 + r32 * 16);
#pragma unroll
              for (int k = 0; k < 4; ++k) if (tau <= 2 * ib[k] + 1) { const int lag = 2 * ib[k] - tau + dt; v4u a = {0u, 0u, 0u, 0u}; if (lag >= 0) a = *(const LAS v4u*)(kbase + lag * 768);
                  acc[k] = MFMA32(__builtin_bit_cast(bf16x8, a), bb, acc[k]); } }
#pragma unroll
          for (int ks = 0; ks < 8; ++ks) { const bf16x8 bb = *(const LAS bf16x8*)(SI + r32 * 136 + 16 * ks + 8 * hf);
#pragma unroll
              for (int k = 0; k < 4; ++k) { const bf16x8 a = *(const GAS bf16x8*)(W2 + ((size_t)g * 1024 + ib[k] * 32 + r32) * 128 + 16 * ks + 8 * hf); acc[k] = MFMA32(a, bb, acc[k]); } }
#pragma unroll
          for (int k = 0; k < 4; ++k)
#pragma unroll
              for (int rg = 0; rg < 4; ++rg) { const int t = 2 * ib[k] + (rg >> 1), h0 = 8 * (rg & 1) + 4 * hf;
                  v2u o; o.x = pk2(gelu_tanh(acc[k][4 * rg]), gelu_tanh(acc[k][4 * rg + 1])); o.y = pk2(gelu_tanh(acc[k][4 * rg + 2]), gelu_tanh(acc[k][4 * rg + 3]));
                  *(GAS v2u*)(ybase + ((size_t)b * SEQ + r32 * SSM_L + t) * ypitch + g * 16 + h0) = o; } }
    }
    __syncthreads();
}

__device__ __forceinline__ float log_sigmoid(float x) { return fminf(x, 0.f) - log1pf(expf(-fabsf(x))); }
__device__ __forceinline__ float siluf_(float x) { return x / (1.0f + __expf(-x)); }
__device__ __forceinline__ void conv8(const bf16* base  , size_t row, int sl, const float* cw, float (&o)[8]) {
#pragma unroll
    for (int i = 0; i < 8; ++i) o[i] = 0.f;
#pragma unroll
    for (int tap = 0; tap < 4; ++tap) {
        const int d = 3 - tap;
        if (sl - d >= 0) {
            const v4u x = *(const GAS v4u*)(base + (row - d) * NP);
            const f32x4 w0 = *(const GAS f32x4*)(cw + tap * 1024), w1 = *(const GAS f32x4*)(cw + tap * 1024 + 4);
            o[0] += w0.x * bflo(x.x); o[1] += w0.y * bfhi(x.x); o[2] += w0.z * bflo(x.y); o[3] += w0.w * bfhi(x.y);
            o[4] += w1.x * bflo(x.z); o[5] += w1.y * bfhi(x.z); o[6] += w1.z * bflo(x.w); o[7] += w1.w * bfhi(x.w);
        }
    }
#pragma unroll
    for (int i = 0; i < 8; ++i) o[i] = siluf_(o[i]);
}
constexpr int MLP = 136;
__device__ __forceinline__ void p_mlstm_dc(Frame& F, int l) {
    LAS bf16* KT = (LAS bf16*)F.lds;
    LAS bf16* VT = KT + 128 * MLP;
    LAS float* GA = (LAS float*)(VT + 160 * MLP);
    const int tid = F.tid, lane = F.lane, r32 = lane & 31, hf = lane >> 5;
    for (int u = F.wg; u < NB * 4 * ML_NC; u += F.G) {
        const int c = u % ML_NC, h = (u / ML_NC) % 4, b = u / (ML_NC * 4);
        const size_t R0 = (size_t)b * SEQ + c * ML_L;
        __syncthreads();
        if (tid < 128) { const float ip = F.G8[(R0 + tid) * 8 + h] + F.in[12][l * 4 + h]; const float fp = F.G8[(R0 + tid) * 8 + 4 + h] + F.in[13][l * 4 + h];
            GA[tid] = log_sigmoid(fp); GA[256 + tid] = ip; }
        for (int i = tid; i < 31 * MLP; i += 512) VT[129 * MLP + i] = 0;
        __syncthreads();
        if (tid < 128) { float s = 0.f; for (int r = 0; r <= tid; ++r) s += GA[r]; GA[128 + tid] = s; }
        __syncthreads();
        float mloc = -INFINITY, gtot = GA[128 + 127];
        for (int r = 0; r < 128; ++r) mloc = fmaxf(mloc, gtot - GA[128 + r] + GA[256 + r]);
        if (tid < 128) GA[384 + tid] = expf(gtot - GA[128 + tid] + GA[256 + tid] - mloc);
        if (tid == 0) { F.STATS[u * 2] = gtot; F.STATS[u * 2 + 1] = mloc; }
        __syncthreads();
#pragma unroll 1
        for (int it = 0; it < 4; ++it) { const int piece = tid + 512 * it, s = piece & 127, cg = piece >> 7;
            float kv[8]; conv8(F.PROJ + C_MK + h * 128 + cg * 8, R0 + s, c * ML_L + s, F.in[2] + (size_t)l * 4096 + 512 + h * 128 + cg * 8, kv);
            const v4u x = *(const GAS v4u*)(F.PROJ + (R0 + s) * NP + C_MV + h * 128 + cg * 8); const float w = GA[384 + s];
            const float vv[8] = {bflo(x.x), bfhi(x.x), bflo(x.y), bfhi(x.y), bflo(x.z), bfhi(x.z), bflo(x.w), bfhi(x.w)};
#pragma unroll
            for (int i = 0; i < 8; ++i) { KT[(cg * 8 + i) * MLP + s] = (bf16)f2bf(kv[i] * 0.08838834764831845f); VT[(cg * 8 + i) * MLP + s] = (bf16)f2bf(vv[i] * w); } }
        if (tid < 128) VT[128 * MLP + tid] = (bf16)f2bf(GA[384 + tid]);
        __syncthreads();
        bf16* dc = F.DC + (size_t)u * DC_UNIT;
        for (int tile = F.wave; tile < 20; tile += 8) { const int rb = tile >> 2, cb = tile & 3;
            f32x16 acc;
#pragma unroll
            for (int i = 0; i < 16; ++i) acc[i] = 0.f;
#pragma unroll
            for (int ks = 0; ks < 8; ++ks) { const bf16x8 a = *(const LAS bf16x8*)(VT + (rb * 32 + r32) * MLP + 16 * ks + 8 * hf); const bf16x8 bb = *(const LAS bf16x8*)(KT + (cb * 32 + r32) * MLP + 16 * ks + 8 * hf);
                acc = MFMA32(a, bb, acc); }
#pragma unroll
            for (int i = 0; i < 16; ++i) { const int row = rb * 32 + crow(i, hf); if (row < DC_ROWS) dc[row * 128 + cb * 32 + r32] = (bf16)f2bf(acc[i]); }
        }
    }
    __syncthreads();
}
__device__ __forceinline__ void p_mlstm_scan(Frame& F, bf16* dcout) {
    for (int u = F.wg; u < NB * 4 * 8; u += F.G) { const int bh = u >> 3, sl = u & 7;
        float a[16], bb[16]; float m = 0.f;
#pragma unroll
        for (int c = 0; c < 16; ++c) { const float g = F.STATS[(bh * 16 + c) * 2], ml = F.STATS[(bh * 16 + c) * 2 + 1];
            if (sl == 0 && F.tid == 0) F.MPREV[bh * 16 + c] = m;
            const float mn = fmaxf(g + m, ml); a[c] = expf(g + m - mn); bb[c] = expf(ml - mn); m = mn; }
        for (int e = sl * 2064 + F.tid; e < (sl + 1) * 2064; e += 512) { float C = 0.f; const bf16* p = F.DC + (size_t)bh * 16 * DC_UNIT + e; bf16* po = dcout + (size_t)bh * 16 * DC_UNIT + e;
#pragma unroll
            for (int c = 0; c < 16; ++c) { const float d = bf2f(p[(size_t)c * DC_UNIT]); po[(size_t)c * DC_UNIT] = (bf16)f2bf(C); C = a[c] * C + bb[c] * d; } }
    }
}
__device__ __forceinline__ void p_mlstm_out(Frame& F, int l, bf16* ybase, int ypitch) {
    const int tid = F.tid, lane = F.lane, r32 = lane & 31, hf = lane >> 5, half = F.wave >> 2, jb = F.wave & 3, ht = tid & 255;
    LAS unsigned char* hb = F.lds + half * 71680;
    LAS bf16* KH = (LAS bf16*)hb; LAS bf16* VT = KH + 128 * MLP; LAS float* GA = (LAS float*)(hb + 69632);
    for (int u0 = F.wg * 2; u0 < NB * 4 * ML_NC; u0 += F.G * 2) {
        const int u = u0 + half; const int c = u % ML_NC, h = (u / ML_NC) % 4, b = u / (ML_NC * 4);
        const size_t R0 = (size_t)b * SEQ + c * ML_L;
        __syncthreads();
        if (ht < 128) { const float ip = F.G8[(R0 + ht) * 8 + h] + F.in[12][l * 4 + h]; const float fp = F.G8[(R0 + ht) * 8 + 4 + h] + F.in[13][l * 4 + h];
            GA[384 + ht] = log_sigmoid(fp); GA[128 + ht] = ip; }
        __syncthreads();
        if (ht < 128) { float s = 0.f; for (int r = 0; r <= ht; ++r) s += GA[384 + r]; GA[ht] = s; }
        __syncthreads();
        if (ht < 128) { float pm = -INFINITY; for (int r = 0; r <= ht; ++r) pm = fmaxf(pm, GA[128 + r] - GA[r]); GA[256 + ht] = pm; }
#pragma unroll 1
        for (int it = 0; it < 8; ++it) { const int piece = ht + 256 * it, s = piece >> 4, cg = piece & 15;
            float kv[8]; conv8(F.PROJ + C_MK + h * 128 + cg * 8, R0 + s, c * ML_L + s, F.in[2] + (size_t)l * 4096 + 512 + h * 128 + cg * 8, kv);
            v4u w; w.x = pk2(kv[0] * 0.08838834764831845f, kv[1] * 0.08838834764831845f); w.y = pk2(kv[2] * 0.08838834764831845f, kv[3] * 0.08838834764831845f);
            w.z = pk2(kv[4] * 0.08838834764831845f, kv[5] * 0.08838834764831845f); w.w = pk2(kv[6] * 0.08838834764831845f, kv[7] * 0.08838834764831845f);
            *(LAS v4u*)(KH + s * MLP + cg * 8) = w; }
#pragma unroll 1
        for (int it = 0; it < 8; ++it) { const int piece = ht + 256 * it, s = piece & 127, cg = piece >> 7;
            const v4u x = *(const GAS v4u*)(F.PROJ + (R0 + s) * NP + C_MV + h * 128 + cg * 8);
            const unsigned short e[8] = {(unsigned short)x.x, (unsigned short)(x.x >> 16), (unsigned short)x.y, (unsigned short)(x.y >> 16), (unsigned short)x.z, (unsigned short)(x.z >> 16), (unsigned short)x.w, (unsigned short)(x.w >> 16)};
#pragma unroll
            for (int i = 0; i < 8; ++i) VT[(cg * 8 + i) * MLP + s] = e[i]; }
        bf16x8 qf[8];
        { const int jl = jb * 32 + r32;
#pragma unroll
            for (int ks = 0; ks < 8; ++ks) { float qv[8]; conv8(F.PROJ + C_MQ + h * 128 + 16 * ks + 8 * hf, R0 + jl, c * ML_L + jl, F.in[2] + (size_t)l * 4096 + h * 128 + 16 * ks + 8 * hf, qv);
                v4u w; w.x = pk2(qv[0], qv[1]); w.y = pk2(qv[2], qv[3]); w.z = pk2(qv[4], qv[5]); w.w = pk2(qv[6], qv[7]); qf[ks] = __builtin_bit_cast(bf16x8, w); } }
        __syncthreads();
        const int jl = jb * 32 + r32;
        const float bcj = GA[jl], mprev = F.MPREV[u];
        const float linter = bcj + mprev, mintra = bcj + GA[256 + jl];
        const float mq = fmaxf(linter, mintra), inter = expf(linter - mq);
        f32x16 o[5];
        const bf16* cp = F.DC + (size_t)u * DC_UNIT;
#pragma unroll
        for (int vb = 0; vb < 5; ++vb) {
#pragma unroll
            for (int i = 0; i < 16; ++i) o[vb][i] = 0.f;
            const int row = vb * 32 + r32; const bool ok = row < DC_ROWS;
#pragma unroll
            for (int ks = 0; ks < 8; ++ks) { v4u a = {0u, 0u, 0u, 0u}; if (ok) a = *(const GAS v4u*)(cp + row * 128 + 16 * ks + 8 * hf);
                o[vb] = MFMA32(__builtin_bit_cast(bf16x8, a), qf[ks], o[vb]); }
#pragma unroll
            for (int i = 0; i < 16; ++i) o[vb][i] *= inter;
        }
        float dsum = 0.f;
#pragma unroll 1
        for (int sb = 0; sb <= jb; ++sb) {
            f32x16 st;
#pragma unroll
            for (int i = 0; i < 16; ++i) st[i] = 0.f;
#pragma unroll
            for (int ks = 0; ks < 8; ++ks) { const bf16x8 a = *(const LAS bf16x8*)(KH + (sb * 32 + r32) * MLP + 16 * ks + 8 * hf); st = MFMA32(a, qf[ks], st); }
            unsigned pw[8];
#pragma unroll
            for (int i = 0; i < 16; i += 2) { float p2[2];
#pragma unroll
                for (int e = 0; e < 2; ++e) { const int s = sb * 32 + crow(i + e, hf); const float ld = bcj - GA[s] + GA[128 + s] - mq; p2[e] = (s <= jl) ? st[i + e] * expf(ld) : 0.f; dsum += p2[e]; }
                pw[i >> 1] = pk2(p2[0], p2[1]); }
#pragma unroll
            for (int step = 0; step < 2; ++step) { v4u pv = {pw[4 * step], pw[4 * step + 1], pw[4 * step + 2], pw[4 * step + 3]}; const bf16x8 pb = __builtin_bit_cast(bf16x8, pv);
#pragma unroll
                for (int vb = 0; vb < 4; ++vb) { const LAS bf16* vr = VT + (vb * 32 + r32) * MLP + sb * 32 + 16 * step + 4 * hf;
                    const v2u lo = *(const LAS v2u*)vr, hi = *(const LAS v2u*)(vr + 8); v4u a = {lo.x, lo.y, hi.x, hi.y};
                    o[vb] = MFMA32(__builtin_bit_cast(bf16x8, a), pb, o[vb]); } }
        }
        dsum += __shfl_xor(dsum, 32);
        const float nq = __shfl(o[4][0], r32);
        const float den = dsum + nq;
        const float dmax = fmaxf(fabsf(den), expf(-mq)); const float rd = 1.0f / dmax;
        float ss = 0.f;
#pragma unroll
        for (int vb = 0; vb < 4; ++vb)
#pragma unroll
            for (int i = 0; i < 16; ++i) { o[vb][i] *= rd; ss += o[vb][i] * o[vb][i]; }
        ss += __shfl_xor(ss, 32);
        const float sc = 1.0f / sqrtf(ss * (1.f / 128.f) + RMS_EPS);
        __syncthreads();
        LAS float* OST = (LAS float*)(hb + jb * 16896);
#pragma unroll
        for (int vb = 0; vb < 4; ++vb)
#pragma unroll
            for (int i = 0; i < 16; ++i) { const int v = vb * 32 + crow(i, hf); OST[r32 * 132 + v] = o[vb][i] * sc * F.in[14][l * 512 + h * 128 + v]; }
        LDS_WAIT(); asm volatile("" ::: "memory");
#pragma unroll 1
        for (int it = 0; it < 8; ++it) { const int piece = lane + 64 * it, rr = piece >> 4, cg = piece & 15;
            bf16* gp = ybase + (R0 + jb * 32 + rr) * ypitch + h * 128 + cg * 8;
            const v4u x = *(const GAS v4u*)(F.PROJ + (R0 + jb * 32 + rr) * NP + C_MO + h * 128 + cg * 8); const f32x4 h0 = *(const LAS f32x4*)(OST + rr * 132 + cg * 8), h1 = *(const LAS f32x4*)(OST + rr * 132 + cg * 8 + 4);
            v4u w; w.x = pk2(sigmoidf_(bflo(x.x)) * h0.x, sigmoidf_(bfhi(x.x)) * h0.y); w.y = pk2(sigmoidf_(bflo(x.y)) * h0.z, sigmoidf_(bfhi(x.y)) * h0.w);
            w.z = pk2(sigmoidf_(bflo(x.z)) * h1.x, sigmoidf_(bfhi(x.z)) * h1.y); w.w = pk2(sigmoidf_(bflo(x.w)) * h1.z, sigmoidf_(bfhi(x.w)) * h1.w);
            *(GAS v4u*)gp = w; }
    }
    __syncthreads();
}

__device__ __forceinline__ void p_kmean(Frame& F) {
    LAS float* PS = (LAS float*)F.lds;
    for (int u = F.wg; u < NB * 8 * 8; u += F.G) { const int n = u & 7, h = (u >> 3) & 7, b = u >> 6;
        const int d = F.tid & 63, part = F.tid >> 6; float s = 0.f;
        const bf16* kp = F.PROJ + ((size_t)b * SEQ + n * 256 + part * 32) * NP + C_AK + h * 64 + d;
        for (int r = 0; r < 32; ++r) s += bf2f(kp[(size_t)r * NP]);
        __syncthreads(); PS[part * 64 + d] = s; __syncthreads();
        if (F.tid < 64) { float t = 0.f; for (int p = 0; p < 8; ++p) t += PS[p * 64 + F.tid]; F.KM[(size_t)u * 64 + F.tid] = t * (1.f / 256.f); }
    }
    __syncthreads();
}
constexpr int ATP = 72;
__device__ __forceinline__ void p_moba(Frame& F, bf16* ybase, int ypitch) {
    LAS bf16* KS = (LAS bf16*)F.lds;
    LAS bf16* VT = KS + 64 * ATP;
    LAS float* BD = (LAS float*)(VT + 64 * ATP);
    LAS float* KMS = BD + 132;
    LAS bf16* OST = (LAS bf16*)(KMS + 512) + F.wave * 32 * ATP;
    const int tid = F.tid, lane = F.lane, r32 = lane & 31, hf = lane >> 5, w = F.wave;
    for (int pu = F.wg; pu < 256; pu += F.G) { const int pr = pu & 3, bh = pu >> 2, h = bh & 7, b = bh >> 3;
#pragma unroll 1
      for (int side = 0; side < 2; ++side) { const int cur = side ? 7 - pr : pr;
        __syncthreads();
        if (tid < 129) { int bk; if (tid < 16) bk = tid; else { bk = 16 + (int)(logf((float)tid * (1.0f / 16.0f)) / 2.0794415416798357f * 16.0f); bk = bk < 31 ? bk : 31; } BD[tid] = F.in[15][h * 32 + bk]; }
        KMS[tid] = F.KM[(size_t)bh * 512 + tid];
        __syncthreads();
        const int ql = w * 32 + r32;
        const size_t qrow = (size_t)b * SEQ + cur * 256 + ql;
        bf16x8 qf[4];
#pragma unroll
        for (int ks = 0; ks < 4; ++ks) qf[ks] = *(const GAS bf16x8*)(F.PROJ + qrow * NP + C_AQ + h * 64 + 16 * ks + 8 * hf);
        unsigned allow = 0u;
        { float gt[7];
#pragma unroll
          for (int n = 0; n < 7; ++n) { float s = 0.f;
#pragma unroll
              for (int ks = 0; ks < 4; ++ks)
#pragma unroll
                  for (int j = 0; j < 8; ++j) s += bf2f((unsigned short)qf[ks][j]) * KMS[n * 64 + 16 * ks + 8 * hf + j];
              s += __shfl_xor(s, 32); gt[n] = s; }
#pragma unroll
          for (int n = 0; n < 7; ++n) { int rank = 0;
#pragma unroll
              for (int n2 = 0; n2 < 7; ++n2) if (n2 != n && n2 < cur) rank += (gt[n2] > gt[n] || (gt[n2] == gt[n] && n2 < n)) ? 1 : 0;
              if (n < cur && rank < 3) allow |= 1u << n; } }
        float mrun = -1e30f, lrun = 0.f; f32x16 o[2];
#pragma unroll
        for (int i = 0; i < 16; ++i) { o[0][i] = 0.f; o[1][i] = 0.f; }
#pragma unroll 1
        for (int t = 0; t < (cur + 1) * 4; ++t) { const int n = t >> 2, kv0 = t * 64;
            __syncthreads();
            { const int kv = tid >> 3, cg = tid & 7; const size_t kr = (size_t)b * SEQ + kv0 + kv;
              const v4u kx = *(const GAS v4u*)(F.PROJ + kr * NP + C_AK + h * 64 + cg * 8); *(LAS v4u*)(KS + kv * ATP + cg * 8) = kx;
              const v4u x = *(const GAS v4u*)(F.PROJ + kr * NP + C_AV + h * 64 + cg * 8);
              const unsigned short e[8] = {(unsigned short)x.x, (unsigned short)(x.x >> 16), (unsigned short)x.y, (unsigned short)(x.y >> 16), (unsigned short)x.z, (unsigned short)(x.z >> 16), (unsigned short)x.w, (unsigned short)(x.w >> 16)};
#pragma unroll
              for (int i = 0; i < 8; ++i) VT[(cg * 8 + i) * ATP + kv] = e[i]; }
            __syncthreads();
            const int qabs = cur * 256 + ql;
            if (n == cur && kv0 > cur * 256 + w * 32 + 31) continue;
            f32x16 st[2];
#pragma unroll
            for (int rb = 0; rb < 2; ++rb) {
#pragma unroll
                for (int i = 0; i < 16; ++i) st[rb][i] = 0.f;
#pragma unroll
                for (int ks = 0; ks < 4; ++ks) { const bf16x8 a = *(const LAS bf16x8*)(KS + (rb * 32 + r32) * ATP + 16 * ks + 8 * hf); st[rb] = MFMA32(a, qf[ks], st[rb]); } }
            const bool blk_ok = (n == cur) || ((allow >> n) & 1u);
            float mx = -1e30f;
#pragma unroll
            for (int rb = 0; rb < 2; ++rb)
#pragma unroll
                for (int i = 0; i < 16; ++i) { const int kv = kv0 + rb * 32 + crow(i, hf); const int dist = qabs - kv; const int dcl = dist < 0 ? 0 : (dist > 128 ? 128 : dist);
                    float x = st[rb][i] * 0.125f + BD[dcl]; x = (blk_ok && dist >= 0) ? x : -1e30f; st[rb][i] = x; mx = fmaxf(mx, x); }
            mx = fmaxf(mx, __shfl_xor(mx, 32));
            const float mnew = fmaxf(mrun, mx), alpha = __expf(mrun - mnew); mrun = mnew;
            float ps = 0.f; unsigned pw[2][8];
#pragma unroll
            for (int rb = 0; rb < 2; ++rb)
#pragma unroll
                for (int i = 0; i < 16; i += 2) { const float p0 = __expf(st[rb][i] - mnew), p1 = __expf(st[rb][i + 1] - mnew); ps += p0 + p1; pw[rb][i >> 1] = pk2(p0, p1); }
            lrun = lrun * alpha + ps;
#pragma unroll
            for (int i = 0; i < 16; ++i) { o[0][i] *= alpha; o[1][i] *= alpha; }
#pragma unroll
            for (int rb = 0; rb < 2; ++rb)
#pragma unroll
                for (int step = 0; step < 2; ++step) { v4u pv = {pw[rb][4 * step], pw[rb][4 * step + 1], pw[rb][4 * step + 2], pw[rb][4 * step + 3]}; const bf16x8 pb = __builtin_bit_cast(bf16x8, pv);
#pragma unroll
                    for (int db = 0; db < 2; ++db) { const LAS bf16* vr = VT + (db * 32 + r32) * ATP + rb * 32 + 16 * step + 4 * hf;
                        const v2u lo = *(const LAS v2u*)vr, hi = *(const LAS v2u*)(vr + 8); v4u a = {lo.x, lo.y, hi.x, hi.y};
                        o[db] = MFMA32(__builtin_bit_cast(bf16x8, a), pb, o[db]); } }
        }
        lrun += __shfl_xor(lrun, 32);
        const float rl = 1.0f / lrun;
#pragma unroll
        for (int db = 0; db < 2; ++db)
#pragma unroll
            for (int i = 0; i < 16; ++i) OST[r32 * ATP + db * 32 + crow(i, hf)] = (bf16)f2bf(o[db][i] * rl);
        LDS_WAIT(); asm volatile("" ::: "memory");
#pragma unroll
        for (int it = 0; it < 4; ++it) { const int piece = lane + 64 * it, rr = piece >> 3, cg = piece & 7;
            const v4u v = *(const LAS v4u*)(OST + rr * ATP + cg * 8);
            *(GAS v4u*)(ybase + ((size_t)b * SEQ + cur * 256 + w * 32 + rr) * ypitch + h * 64 + cg * 8) = v; }
        LDS_WAIT(); asm volatile("" ::: "memory");
      }
    }
    __syncthreads();
}

constexpr int N_STEPS = 2 + 10 * DEPTH;
__global__ void __launch_bounds__(NWAVES * 64, 2) fwd(Args args) {
    extern __shared__ __attribute__((aligned(16))) unsigned char lds[];
    Frame F;
    F.lds = (LAS unsigned char*)lds;
    F.tid = threadIdx.x; F.lane = F.tid & 63; F.wave = __builtin_amdgcn_readfirstlane(F.tid >> 6);
    F.G = gridDim.x; F.wg = blockIdx.x;
    F.in = args.in; F.out = args.out; F.ws = args.ws;
    unsigned char* ws = args.ws;
    F.XB = (bf16*)(ws + WS_XB); F.PROJ = (bf16*)(ws + WS_PROJ); F.DC = (bf16*)(ws + WS_DC); F.SLOC = (float*)(ws + WS_SLOC);
    F.RSTD = (float*)(ws + WS_SMALL + SM_RSTD); F.G8 = (float*)(ws + WS_SMALL + SM_G8); F.KM = (float*)(ws + WS_SMALL + SM_KM);
    F.STATS = (float*)(ws + WS_SMALL + SM_STATS); F.MPREV = (float*)(ws + WS_SMALL + SM_MPREV); F.WG8 = (float*)(ws + WS_SMALL + SM_WG8);
    volatile LAS unsigned* MISC = (volatile LAS unsigned*)(F.lds + MISC_OFF);
    for (int u = F.tid; u < (LDS_BYTES - LDSCTL_OFF) / 4; u += NWAVES * 64) ((LAS unsigned*)(F.lds + LDSCTL_OFF))[u] = 0u;
    __syncthreads();
    const int lo = args.s_lo, hi = args.s_hi;
    XcdBarrier bar; bar.bar = (unsigned*)(ws + WS_CTL) + CW_BAR; bar.x = 0; bar.st = nullptr;
    if (hi - lo > 1) bar = xcd_barrier_post((unsigned*)(ws + WS_CTL) + CW_BAR, MISC + 8);
#define IN(k) (lo <= (k) && (k) < hi)
#define SEAM(k) do { if ((k) + 1 < hi) xcd_barrier(bar); } while (0)

    if (IN(0)) {
#pragma unroll 1
        for (int r = 0; r < REP_ROWS; ++r) p_convert(F);
        SEAM(0); }
    if (IN(1)) { p_rows(F, args.in[0], nullptr, nullptr, false, true, 0, F.out, F.XB, F.RSTD, F.G8); p_ssm_tables(F, 0); SEAM(1); }

    for (int l = 0; l < DEPTH; ++l) {
        const int s0 = 2 + 10 * l;
        unsigned char* ws = args.ws; asm volatile("" : "+s"(ws));
        float* outp = args.out; asm volatile("" : "+s"(outp));
        { int t_ = threadIdx.x; asm volatile("" : "+v"(t_)); F.tid = t_; F.lane = t_ & 63; F.wave = __builtin_amdgcn_readfirstlane(t_ >> 6);
          int w_ = blockIdx.x; asm volatile("" : "+s"(w_)); F.wg = w_; }
        F.out = outp; F.ws = ws;
        F.XB = (bf16*)(ws + WS_XB); F.PROJ = (bf16*)(ws + WS_PROJ); F.DC = (bf16*)(ws + WS_DC); F.SLOC = (float*)(ws + WS_SLOC);
        F.RSTD = (float*)(ws + WS_SMALL + SM_RSTD); F.G8 = (float*)(ws + WS_SMALL + SM_G8); F.KM = (float*)(ws + WS_SMALL + SM_KM);
        F.STATS = (float*)(ws + WS_SMALL + SM_STATS); F.MPREV = (float*)(ws + WS_SMALL + SM_MPREV); F.WG8 = (float*)(ws + WS_SMALL + SM_WG8);
        unsigned char* wl = ws + WS_WT + (size_t)l * WT_LAYER;
        const float* xold = (l == 0) ? args.in[0] : outp;
        if (IN(s0 + 0)) {
            pg8::Gemm g{F.XB, (const bf16*)(wl + WT_IN), M, NP, D, D, D}; pg8::StaticOrder S; S.init(M, NP, F.G, F.wg);
            pg8::EpiProj E{F.PROJ, NP, F.RSTD, C_G / 256};
            _Pragma("unroll 1") for (int r = 0; r < REP_GEMM; ++r) pg8::gemm_phase<pg8::EpiProj, pg8::StaticOrder, true, true>(F.lds + RING_OFF, g, S, E);
            SEAM(s0 + 0);
        }
        if (IN(s0 + 1)) {
#pragma unroll 1
            for (int r = 0; r < REP_MOBA; ++r) p_kmean(F);
#pragma unroll 1
            for (int r = REP_SSM - 1; r >= 0; --r) p_ssm(F, l, r ? F.XB : F.PROJ + C_U, r ? 512 : NP);
#pragma unroll 1
            for (int r = 0; r < REP_ML; ++r) p_mlstm_dc(F, l);
            SEAM(s0 + 1); }
        if (IN(s0 + 2)) {
#pragma unroll 1
            for (int r = REP_ML - 1; r >= 0; --r) p_mlstm_scan(F, r ? F.XB : F.DC);
            __syncthreads();
#pragma unroll 1
            for (int r = REP_MOBA - 1; r >= 0; --r) p_moba(F, r ? F.XB + (size_t)M * 512 : F.PROJ + C_YMOBA, r ? 512 : NP);
            SEAM(s0 + 2); }
        if (IN(s0 + 3)) {
#pragma unroll 1
            for (int r = REP_ML - 1; r >= 0; --r) p_mlstm_out(F, l, r ? F.XB : F.PROJ + C_YML, r ? 512 : NP);
            pg8::Gemm g{F.PROJ + C_U, (const bf16*)(wl + WT_GLU), M, 512, 512, NP, 512}; pg8::StaticOrder S; S.init(M, 512, F.G, F.wg);
            pg8::EpiGlu E{F.PROJ + C_U, F.PROJ + C_YSSM, NP};
            _Pragma("unroll 1") for (int r = 0; r < REP_GEMM; ++r) pg8::gemm_phase<pg8::EpiGlu, pg8::StaticOrder, false, true>(F.lds + RING_OFF, g, S, E);
            SEAM(s0 + 3);
        }
        if (IN(s0 + 4)) {
            pg8::StaticOrder S; S.init(M, D, F.G, F.wg);
            _Pragma("unroll 1") for (int r = 0; r < REP_GEMM; ++r) {
            { pg8::Gemm g{F.PROJ + C_YSSM, (const bf16*)(wl + WT_BR), M, D, 512, NP, 1536}; pg8::EpiBranch<1> E{F.PROJ + C_G, NP, F.XB, D};
              pg8::gemm_phase<pg8::EpiBranch<1>, pg8::StaticOrder, false, true>(F.lds + RING_OFF, g, S, E); }
            { pg8::Gemm g{F.PROJ + C_YML, (const bf16*)(wl + WT_BR) + 512, M, D, 512, NP, 1536}; pg8::EpiBranch<0> E{F.PROJ + C_G + 1024, NP, F.XB, D};
              pg8::gemm_phase<pg8::EpiBranch<0>, pg8::StaticOrder, false, true>(F.lds + RING_OFF, g, S, E); }
            { pg8::Gemm g{F.PROJ + C_YMOBA, (const bf16*)(wl + WT_BR) + 1024, M, D, 512, NP, 1536}; pg8::EpiBranch<0> E{F.PROJ + C_G + 2048, NP, F.XB, D};
              pg8::gemm_phase<pg8::EpiBranch<0>, pg8::StaticOrder, false, true>(F.lds + RING_OFF, g, S, E); }
            }
            SEAM(s0 + 4);
        }
        if (IN(s0 + 5)) {
            pg8::Gemm g{F.XB, (const bf16*)(wl + WT_OUT), M, D, D, D, D}; pg8::StaticOrder S; S.init(M, D, F.G, F.wg);
            pg8::EpiF32 E{(float*)(ws + WS_PROJ + PROJ_TMP1), D};
            _Pragma("unroll 1") for (int r = 0; r < REP_GEMM; ++r) pg8::gemm_phase<pg8::EpiF32, pg8::StaticOrder, false, true>(F.lds + RING_OFF, g, S, E);
            SEAM(s0 + 5);
        }
        if (IN(s0 + 6)) {
#pragma unroll 1
            for (int r = REP_ROWS - 1; r >= 0; --r) p_rows(F, xold, (const float*)(ws + WS_PROJ + PROJ_TMP1), args.in[23] + l * 1024, true, true, -1, r ? (float*)(ws + WS_PROJ + 64 * MiB) : F.out, r ? (bf16*)(ws + WS_PROJ + 128 * MiB) : F.XB, r ? (float*)(ws + WS_DC) : F.RSTD, r ? (float*)(ws + WS_DC + MiB) : F.G8);
            SEAM(s0 + 6); }
        if (IN(s0 + 7)) {
            pg8::Gemm g{F.XB, (const bf16*)(wl + WT_FF1), M, FF, D, D, D}; pg8::StaticOrder S; S.init(M, FF, F.G, F.wg);
            pg8::EpiFF1 E{(bf16*)(ws + WS_PROJ + PROJ_HFF), FF, F.RSTD};
            _Pragma("unroll 1") for (int r = 0; r < REP_GEMM; ++r) pg8::gemm_phase<pg8::EpiFF1, pg8::StaticOrder, true, true>(F.lds + RING_OFF, g, S, E);
            SEAM(s0 + 7);
        }
        if (IN(s0 + 8)) {
            pg8::Gemm g{(const bf16*)(ws + WS_PROJ + PROJ_HFF), (const bf16*)(wl + WT_FF2), M, D, FF, FF, FF}; pg8::StaticOrder S; S.init(M, D, F.G, F.wg);
            pg8::EpiF32 E{(float*)(ws + WS_PROJ + PROJ_TMP2), D};
            _Pragma("unroll 1") for (int r = 0; r < REP_GEMM; ++r) pg8::gemm_phase<pg8::EpiF32, pg8::StaticOrder, false, true>(F.lds + RING_OFF, g, S, E);
            SEAM(s0 + 8);
        }
        if (IN(s0 + 9)) {
#pragma unroll 1
            for (int r = REP_ROWS - 1; r >= 0; --r) p_rows(F, outp, (const float*)(ws + WS_PROJ + PROJ_TMP2), args.in[25] + l * 1024, true, l + 1 < DEPTH, l + 1 < DEPTH ? l + 1 : -1, r ? (float*)(ws + WS_PROJ) : F.out, r ? (bf16*)(ws + WS_PROJ + 64 * MiB) : F.XB, r ? (float*)(ws + WS_DC) : F.RSTD, r ? (float*)(ws + WS_DC + MiB) : F.G8);
            if (l + 1 < DEPTH) p_ssm_tables(F, l + 1);
            SEAM(s0 + 9); }
    }
#undef IN
#undef SEAM
}

extern "C" void kernel_launch(void* const* d_in, const int* in_sizes, int n_in, void* d_out, int out_size, void* d_ws, size_t ws_size, hipStream_t stream) {
    static int grid = 0;
    if (grid == 0) {
        if (n_in != 26 || out_size != M * D || ws_size < WS_END) { fprintf(stderr, "kernel_launch: unexpected shapes: n_in %d out %d ws %zu (need %zu)\n", n_in, out_size, ws_size, (size_t)WS_END); grid = -1; return; }
        int dev = 0, cus = 0, per_cu = 0;
        if (hipGetDevice(&dev) != hipSuccess || hipDeviceGetAttribute(&cus, hipDeviceAttributeMultiprocessorCount, dev) != hipSuccess) { grid = -1; return; }
        if (hipFuncSetAttribute((const void*)fwd, hipFuncAttributeMaxDynamicSharedMemorySize, LDS_BYTES) != hipSuccess) { fprintf(stderr, "kernel_launch: hipFuncSetAttribute failed\n"); grid = -1; return; }
        if (hipOccupancyMaxActiveBlocksPerMultiprocessor(&per_cu, (const void*)fwd, NWAVES * 64, LDS_BYTES) != hipSuccess || per_cu < 1) fprintf(stderr, "kernel_launch: occupancy query says %d\n", per_cu);
        (void)hipGetLastError();
        grid = cus;
    }
    if (grid < 0) return;
    if (hipMemsetAsync((char*)d_ws + WS_CTL, 0, CTL_ZERO_BYTES, stream) != hipSuccess) return;
    Args a{};
    for (int i = 0; i < 26; ++i) a.in[i] = (const float*)d_in[i];
    a.out = (float*)d_out; a.ws = (unsigned char*)d_ws;
#if MK_ONE_LAUNCH
    a.s_lo = 0; a.s_hi = N_STEPS;
    hipLaunchKernelGGL(fwd, dim3(grid), dim3(NWAVES * 64), LDS_BYTES, stream, a);
#else
    for (int s = 0; s < N_STEPS; ++s) { a.s_lo = s; a.s_hi = s + 1; hipLaunchKernelGGL(fwd, dim3(grid), dim3(NWAVES * 64), LDS_BYTES, stream, a); }
#endif
}
```
